# Optimizing an MI355X kernel written in HIP

```python
import functools
import jax, jax.numpy as jnp
from jax import lax
import numpy as np

D_MODEL = 1024
BATCH = 2
SEQ = 8192
DEPTH = 2
DEC_BATCH = 128
DEC_SEQ = 1
PAST_LEN = 2048
PAGE_SIZE = 128

D_MIX = D_MODEL
W_A = D_MIX // 4
W_B = D_MIX // 4
W_C = D_MIX // 4
W_D = D_MIX - W_A - W_B - W_C
N_HEADS_D = 4
HEAD_DIM = W_D // N_HEADS_D
CONV_A_WIDTH = 3
CONV_B_WIDTH = 31
POOL_WINDOWS = (2, 4, 8, 16)
N_POOL_GROUPS = len(POOL_WINDOWS)
POOL_GROUP = W_C // N_POOL_GROUPS
POOL_HIST = max(POOL_WINDOWS) - 1
Q_BLOCK = 128
LN_EPS = 1e-5
SB_BIAS_INIT = -5.0
DEEPNORM_ALPHA = (2 * DEPTH) ** 0.25
DEEPNORM_BETA = (8 * DEPTH) ** -0.25
D_IN = 4 * W_A + 3 * W_B + 2 * W_C + 4 * W_D

kernel_name = "hybrid_conv_pool_stickbreak_decoder_step"


def _split_in(u):
    sizes = (W_A,) * 4 + (W_B,) * 3 + (W_C,) * 2 + (W_D,) * 4
    idx = []
    off = 0
    for s in sizes[:-1]:
        off += s
        idx.append(off)
    return jnp.split(u, idx, axis=-1)


def _layernorm(x, g, b):
    xf = x.astype(jnp.float32)
    mu = jnp.mean(xf, axis=-1, keepdims=True)
    var = jnp.mean(jnp.square(xf - mu), axis=-1, keepdims=True)
    return ((xf - mu) * lax.rsqrt(var + LN_EPS) * g + b).astype(x.dtype)


def _dwconv(u_ext, w):
    c = w.shape[1]
    return lax.conv_general_dilated(u_ext, w[:, None, :].astype(u_ext.dtype), window_strides=(1,),
                                    padding='VALID', dimension_numbers=('NWC', 'WIO', 'NWC'),
                                    feature_group_count=c)


def _pool_mix(v_ext, start_pos, pool_w, pool_scale):
    b_, l_ext, _ = v_ext.shape
    l = l_ext - POOL_HIST
    vf = v_ext.astype(jnp.float32)
    cs = jnp.concatenate([jnp.zeros((b_, 1, W_C), jnp.float32), jnp.cumsum(vf, axis=1)], axis=1)
    pos = start_pos + jnp.arange(l)
    outs = []
    for g, w in enumerate(POOL_WINDOWS):
        sl = slice(g * POOL_GROUP, (g + 1) * POOL_GROUP)
        win = cs[:, POOL_HIST + 1:, sl] - cs[:, POOL_HIST + 1 - w:POOL_HIST + 1 - w + l, sl]
        cnt = jnp.minimum(pos + 1, w).astype(jnp.float32)
        outs.append(win / cnt[None, :, None])
    pooled = jnp.stack(outs, axis=2)
    v_new = vf[:, POOL_HIST:, :].reshape(b_, l, N_POOL_GROUPS, POOL_GROUP)
    y = jnp.einsum('blgc,gcd->blgd', pooled - v_new, pool_w.astype(jnp.float32))
    y = y.reshape(b_, l, W_C) * pool_scale.astype(jnp.float32)
    return y.astype(v_ext.dtype)


def _stick_breaking_block(q, k, v, bias, q_pos, k_pos):
    z = jnp.einsum('bqhd,bshd->bhqs', q.astype(jnp.float32), k.astype(jnp.float32)) * (HEAD_DIM ** -0.5)
    z = z + bias.astype(jnp.float32)[None, :, None, None]
    mask = (k_pos[None, :] < q_pos[:, None])[None, None]
    log_keep = jnp.where(mask, jax.nn.log_sigmoid(-z), 0.0)
    later = lax.cumsum(log_keep, axis=3, reverse=True) - log_keep
    a = jnp.where(mask, jnp.exp(jax.nn.log_sigmoid(z) + later), 0.0)
    return jnp.einsum('bhqs,bshd->bqhd', a, v.astype(jnp.float32)).astype(q.dtype)


def _stick_breaking_prompt(q, k, v, bias):
    b_, l, h, dh = q.shape
    nb = l // Q_BLOCK
    qb = q.reshape(b_, nb, Q_BLOCK, h, dh).transpose(1, 0, 2, 3, 4)
    k_pos = jnp.arange(l)

    def body(args):
        qi, bi = args
        q_pos = bi * Q_BLOCK + jnp.arange(Q_BLOCK)
        return _stick_breaking_block(qi, k, v, bias, q_pos, k_pos)

    out = lax.map(body, (qb, jnp.arange(nb)))
    return out.transpose(1, 0, 2, 3, 4).reshape(b_, l, h, dh)


def _stick_breaking_sample(q, k, v, bias, k_past, v_past):
    k_all = jnp.concatenate([k_past.astype(k.dtype), k], axis=1)
    v_all = jnp.concatenate([v_past.astype(v.dtype), v], axis=1)
    q_pos = k_past.shape[1] + jnp.arange(q.shape[1])
    k_pos = jnp.arange(k_all.shape[1])
    return _stick_breaking_block(q, k_all, v_all, bias, q_pos, k_pos)


def _layer(x, hist_a, hist_b, hist_c, attend, start_pos, w_in, conv_a_w, conv_b_w, conv_b_b,
           norm_b_g, norm_b_b, pool_w, pool_scale, w_out, ln_g, ln_b, sb_bias):
    b_, l, _ = x.shape
    u = jnp.einsum('bld,de->ble', x, w_in)
    (a_h, a_b, a_c, a_g, b_a, b_b, b_g, c_v, c_g, d_q, d_k, d_v, d_g) = _split_in(u)
    a_ext = jnp.concatenate([hist_a.astype(u.dtype), a_c * a_h], axis=1)
    y_a = a_b * _dwconv(a_ext, conv_a_w) * jax.nn.silu(a_g)
    b_ext = jnp.concatenate([hist_b.astype(u.dtype), b_a * jax.nn.sigmoid(b_b)], axis=1)
    b_c = _dwconv(b_ext, conv_b_w) + conv_b_b
    y_b = jax.nn.silu(_layernorm(b_c, norm_b_g, norm_b_b)) * jax.nn.silu(b_g)
    c_ext = jnp.concatenate([hist_c.astype(u.dtype), c_v], axis=1)
    y_c = _pool_mix(c_ext, start_pos, pool_w, pool_scale) * jax.nn.silu(c_g)
    q = d_q.reshape(b_, l, N_HEADS_D, HEAD_DIM)
    k = d_k.reshape(b_, l, N_HEADS_D, HEAD_DIM)
    v = d_v.reshape(b_, l, N_HEADS_D, HEAD_DIM)
    y_d = attend(q, k, v, sb_bias).reshape(b_, l, W_D) * jax.nn.silu(d_g)
    mix = jnp.concatenate([y_a, y_b, y_c, y_d], axis=-1)
    y = _layernorm(DEEPNORM_ALPHA * x + jnp.einsum('ble,ed->bld', mix, w_out), ln_g, ln_b)
    return (y, a_ext[:, -(CONV_A_WIDTH - 1):], b_ext[:, -(CONV_B_WIDTH - 1):],
            c_ext[:, -POOL_HIST:], k, v)


def setup_inputs(seed: int = 0) -> dict:
    key = jax.random.key(seed)
    ks = jax.random.split(key, 24)
    n_pages = PAST_LEN // PAGE_SIZE
    n_used = DEC_BATCH * n_pages
    n_pool = n_used + n_used // 4
    f32 = jnp.float32
    nrm = lambda k, shape: jax.random.normal(k, shape, f32)
    page_table = jax.random.permutation(ks[0], n_pool)[:n_used].reshape(DEC_BATCH, n_pages).astype(jnp.int32)
    return {
        'x_prompt': nrm(ks[1], (BATCH, SEQ, D_MODEL)),
        'x_sample': nrm(ks[2], (DEC_BATCH, DEC_SEQ, D_MODEL)),
        'cache_k': nrm(ks[3], (DEPTH, n_pool, PAGE_SIZE, N_HEADS_D, HEAD_DIM)),
        'cache_v': nrm(ks[4], (DEPTH, n_pool, PAGE_SIZE, N_HEADS_D, HEAD_DIM)),
        'page_table': page_table,
        'state_conv_a': nrm(ks[5], (DEPTH, DEC_BATCH, CONV_A_WIDTH - 1, W_A)),
        'state_conv_b': 0.5 * nrm(ks[6], (DEPTH, DEC_BATCH, CONV_B_WIDTH - 1, W_B)),
        'state_pool': nrm(ks[7], (DEPTH, DEC_BATCH, POOL_HIST, W_C)),
        'w_in': nrm(ks[8], (DEPTH, D_MODEL, D_IN)) * D_MODEL ** -0.5,
        'conv_a_w': nrm(ks[9], (DEPTH, CONV_A_WIDTH, W_A)) * CONV_A_WIDTH ** -0.5,
        'conv_b_w': nrm(ks[10], (DEPTH, CONV_B_WIDTH, W_B)) * CONV_B_WIDTH ** -0.5,
        'conv_b_b': 0.02 * nrm(ks[11], (DEPTH, W_B)),
        'norm_b_g': 1.0 + 0.02 * nrm(ks[12], (DEPTH, W_B)),
        'norm_b_b': 0.02 * nrm(ks[13], (DEPTH, W_B)),
        'pool_w': nrm(ks[14], (DEPTH, N_POOL_GROUPS, POOL_GROUP, POOL_GROUP)) * POOL_GROUP ** -0.5,
        'pool_scale': 1.0 + 0.1 * nrm(ks[15], (DEPTH, W_C)),
        'w_out': nrm(ks[16], (DEPTH, D_MIX, D_MODEL)) * (D_MIX ** -0.5 * DEEPNORM_BETA),
        'ln_g': 1.0 + 0.02 * nrm(ks[17], (DEPTH, D_MODEL)),
        'ln_b': 0.02 * nrm(ks[18], (DEPTH, D_MODEL)),
        'sb_bias': SB_BIAS_INIT + 0.1 * nrm(ks[19], (DEPTH, N_HEADS_D)),
    }


def reference(x_prompt, x_sample, cache_k, cache_v, page_table, state_conv_a, state_conv_b, state_pool,
              w_in, conv_a_w, conv_b_w, conv_b_b, norm_b_g, norm_b_b, pool_w, pool_scale, w_out,
              ln_g, ln_b, sb_bias):
    bp = x_prompt.shape[0]
    bs = x_sample.shape[0]
    zero_a = jnp.zeros((bp, CONV_A_WIDTH - 1, W_A), x_prompt.dtype)
    zero_b = jnp.zeros((bp, CONV_B_WIDTH - 1, W_B), x_prompt.dtype)
    zero_c = jnp.zeros((bp, POOL_HIST, W_C), x_prompt.dtype)
    hp, hs = x_prompt, x_sample
    ca_p, ca_s, cb_p, cb_s, pl_p, pl_s, kp_l, vp_l, ks_l, vs_l = ([] for _ in range(10))
    for l in range(DEPTH):
        lw = dict(w_in=w_in[l], conv_a_w=conv_a_w[l], conv_b_w=conv_b_w[l], conv_b_b=conv_b_b[l],
                  norm_b_g=norm_b_g[l], norm_b_b=norm_b_b[l], pool_w=pool_w[l],
                  pool_scale=pool_scale[l], w_out=w_out[l], ln_g=ln_g[l], ln_b=ln_b[l],
                  sb_bias=sb_bias[l])
        hp, sa, sb, sc, kp, vp = _layer(hp, zero_a, zero_b, zero_c, _stick_breaking_prompt, 0, **lw)
        k_past = cache_k[l][page_table].reshape(bs, -1, N_HEADS_D, HEAD_DIM)
        v_past = cache_v[l][page_table].reshape(bs, -1, N_HEADS_D, HEAD_DIM)
        attend = functools.partial(_stick_breaking_sample, k_past=k_past, v_past=v_past)
        hs, ta, tb, tc, kn, vn = _layer(hs, state_conv_a[l], state_conv_b[l], state_pool[l], attend,
                                        k_past.shape[1], **lw)
        ca_p.append(sa); ca_s.append(ta); cb_p.append(sb); cb_s.append(tb)
        pl_p.append(sc); pl_s.append(tc); kp_l.append(kp); vp_l.append(vp)
        ks_l.append(kn); vs_l.append(vn)
    return (hp, hs,
            jnp.stack(ca_p), jnp.stack(ca_s),
            jnp.stack(cb_p), jnp.stack(cb_s),
            jnp.stack(pl_p), jnp.stack(pl_s),
            jnp.stack(kp_l), jnp.stack(vp_l),
            jnp.stack(ks_l), jnp.stack(vs_l))
```

```cpp
#include <hip/hip_runtime.h>
#include <cstdio>
#include <cstdint>
namespace pg8 {
#define PG8_LAS __attribute__((address_space(3)))
typedef unsigned short bf16_t;
typedef short bf16x8 __attribute__((ext_vector_type(8)));
typedef float f32x4 __attribute__((ext_vector_type(4)));
typedef unsigned u32x4 __attribute__((ext_vector_type(4)));
constexpr int BM = 256, BK = 64, HALF = 128, HTB = HALF * BK * 2  , STAGE_BYTES = 8 * HTB, NXCD = 8, WGM = 8;

__host__ __device__ __forceinline__ int lds_byte(int r, int c) { const int st = (r >> 4) * 2 + (c >> 5), rr = r & 15, cc = c & 31, ob = rr * 64 + cc * 2; return st * 1024 + (ob ^ (((ob >> 9) & 1) << 5)); }
__host__ __device__ __forceinline__ void stage_rc(int b, int& R, int& C) { const int st = b / 1024, sb = b % 1024, swz = sb ^ (((sb >> 9) & 1) << 5); R = (st >> 1) * 16 + swz / 64; C = (st & 1) * 32 + (swz % 64) / 2; }
__host__ __device__ __forceinline__ int perm32(int rho) { const int n = rho >> 4, i = rho & 15; return 8 * (i >> 2) + 4 * n + (i & 3); }

struct Unit { int pm, pn; };
struct Gemm { const bf16_t* A; const bf16_t* Bt; int M, N, K; };

struct StaticOrder {
    int nM, nN, nwg, G, c;
    __host__ __device__ void init(int M, int N, int G_, int c_) { nM = M / BM; nN = N / BM; nwg = nM * nN; G = G_; c = c_; }
    __host__ __device__ bool next(int i, Unit& u) const {
        const long L = (long)i * G + c; if (L >= nwg) return false;
        int wgid = (int)L; { const int q = nwg / NXCD, r = nwg % NXCD, xcd = wgid % NXCD, off = wgid / NXCD; wgid = (xcd < r ? xcd * (q + 1) : r * (q + 1) + (xcd - r) * q) + off; }
        const int nig = WGM * nN, gid = wgid / nig, fm = gid * WGM, gsz = (nM - fm) < WGM ? (nM - fm) : WGM;
        u.pm = fm + ((wgid % nig) % gsz); u.pn = (wgid % nig) / gsz; return true;
    }
    __device__ __forceinline__ void a_ready(const Unit&) const {}
    __device__ __forceinline__ void done(const Unit&) const {}
};

__device__ __forceinline__ unsigned cvt_pk_bf16(float lo, float hi) { unsigned r; asm volatile("v_cvt_pk_bf16_f32 %0, %1, %2" : "=v"(r) : "v"(lo), "v"(hi)); return r; }
typedef float f32x2 __attribute__((ext_vector_type(2)));
typedef unsigned u32x4 __attribute__((ext_vector_type(4)));
constexpr float QSCALE = 0.125f * 1.4426950408889634f;
struct EpiIn {
    static constexpr bool PERM = true, AFTER_DRAIN = false;
    bf16_t* U; bf16_t* Q; bf16_t* KT; bf16_t* VT; float* kout; float* vout; float* ksout; float* vsout;
    __device__ __forceinline__ void operator()(const f32x4 (&acc)[2][2][4][2], const Unit& u, int wr, int wc, int fr, int fq) const {
        const int pn = u.pn, pm = u.pm;
        int rowl = wr * 64 + fr, cl = wc * 32 + 8 * fq;
        asm volatile("" : "+v"(rowl), "+v"(cl));
        if (pm < 64 && pn >= 9 && pn <= 11) {
#pragma unroll
            for (int ai = 0; ai < 2; ++ai)
#pragma unroll
                for (int m = 0; m < 4; ++m) {
                    const int row = pm * 256 + ai * 128 + m * 16 + rowl, b = row >> 13, t = row & 8191;
#pragma unroll
                    for (int bj = 0; bj < 2; ++bj) {
                        const int c = bj * 128 + cl, head = c >> 6, d = c & 63, bh = b * 4 + head;
                        f32x4 v0 = acc[ai][bj][m][0], v1 = acc[ai][bj][m][1];
                        if (pn == 9) { v0 = v0 * QSCALE; v1 = v1 * QSCALE; }
                        u32x4 w; w.x = cvt_pk_bf16(v0[0], v0[1]); w.y = cvt_pk_bf16(v0[2], v0[3]); w.z = cvt_pk_bf16(v1[0], v1[1]); w.w = cvt_pk_bf16(v1[2], v1[3]);
                        if (pn == 9) { *(u32x4*)(Q + ((size_t)bh * 8192 + t) * 64 + d) = w; }
                        else if (pn == 10) {
                            float* o = kout + (size_t)row * 256 + c; *(f32x4*)o = v0; *(f32x4*)(o + 4) = v1;
                            *(u32x4*)(KT + (size_t)bh * 524288 + (size_t)(t >> 6) * 4096 + (d >> 3) * 512 + (t & 63) * 8) = w;
                        } else {
                            float* o = vout + (size_t)row * 256 + c; *(f32x4*)o = v0; *(f32x4*)(o + 4) = v1;
                            *(u32x4*)(VT + (size_t)bh * 524288 + (size_t)(t >> 6) * 4096 + (d >> 5) * 2048 + ((t >> 4) & 3) * 512 + (t & 15) * 32 + ((d >> 3) & 3) * 8) = w;
                        }
                    }
                }
        } else if (pm == 64 && (pn == 10 || pn == 11)) {
            float* ob = (pn == 10) ? ksout : vsout;
#pragma unroll
            for (int m = 0; m < 4; ++m) {
                const int i = m * 16 + rowl;
#pragma unroll
                for (int bj = 0; bj < 2; ++bj) { const int c = bj * 128 + cl; float* o = ob + (size_t)i * 256 + c; *(f32x4*)o = acc[0][bj][m][0]; *(f32x4*)(o + 4) = acc[0][bj][m][1]; }
            }
        } else {
            const float sc = (pn == 9) ? QSCALE : 1.0f;
#pragma unroll
            for (int ai = 0; ai < 2; ++ai)
#pragma unroll
                for (int m = 0; m < 4; ++m) {
                    const int row = pm * 256 + ai * 128 + m * 16 + rowl;
#pragma unroll
                    for (int bj = 0; bj < 2; ++bj) {
                        const int c = bj * 128 + cl;
                        const f32x4 v0 = acc[ai][bj][m][0] * sc, v1 = acc[ai][bj][m][1] * sc;
                        u32x4 w; w.x = cvt_pk_bf16(v0[0], v0[1]); w.y = cvt_pk_bf16(v0[2], v0[3]); w.z = cvt_pk_bf16(v1[0], v1[1]); w.w = cvt_pk_bf16(v1[2], v1[3]);
                        *(u32x4*)(U + (size_t)row * 3328 + pn * 256 + c) = w;
                    }
                }
        }
    }
};
struct EpiPre {
    static constexpr bool PERM = true, AFTER_DRAIN = false;
    const float* base; float* pre; float alpha;
    __device__ __forceinline__ void operator()(const f32x4 (&acc)[2][2][4][2], const Unit& u, int wr, int wc, int fr, int fq) const {
        int rowl = wr * 64 + fr, cl = wc * 32 + 8 * fq;
        asm volatile("" : "+v"(rowl), "+v"(cl));
#pragma unroll
        for (int ai = 0; ai < 2; ++ai)
#pragma unroll
            for (int m = 0; m < 4; ++m) {
                const int row = u.pm * 256 + ai * 128 + m * 16 + rowl;
#pragma unroll
                for (int bj = 0; bj < 2; ++bj) {
                    const size_t off = (size_t)row * 1024 + u.pn * 256 + bj * 128 + cl;
                    const f32x4 b0 = *(const f32x4*)(base + off), b1 = *(const f32x4*)(base + off + 4);
                    *(f32x4*)(pre + off) = b0 * alpha + acc[ai][bj][m][0]; *(f32x4*)(pre + off + 4) = b1 * alpha + acc[ai][bj][m][1];
                }
            }
    }
};
template <class Epi, class Sched, bool ALIGN_EPI = false, bool SP2 = false>
__device__ __forceinline__ void gemm_phase(PG8_LAS unsigned char* lds, const Gemm g, const Sched& S, const Epi& E) {
    int tid_ = threadIdx.x; asm volatile("" : "+v"(tid_));
    const int tid = tid_, wid = __builtin_amdgcn_readfirstlane(tid >> 6), lane = tid & 63, wr = wid >> 2, wc = wid & 3, fr = lane & 15, fq = lane >> 4;
    const int K = g.K, nt = K / BK;
    unsigned voffA[2], voffB[2];
#pragma unroll
    for (int i = 0; i < 2; ++i) { int R, C; stage_rc(tid * 16 + i * 8192, R, C); const int Rb = Epi::PERM ? ((R & ~31) + perm32(R & 31)) : R;
        voffA[i] = (unsigned)(R * K + C) * 2u; voffB[i] = (unsigned)(Rb * K + C) * 2u; }
    const size_t kstep = (size_t)(BK * 2);
    const size_t hstep = (size_t)HALF * K * 2;
    const size_t tstep = 2 * hstep;
    const unsigned ldsw = (unsigned)wid * 1024u;
    const int aoff = lds_byte(wr * 64 + fr, fq * 8), boff = lds_byte(wc * 32 + fr, fq * 8);
#define PG8_SA(b, h) (((b) * 2 + (h)) * HTB)
#define PG8_SB(b, h) ((4 + (b) * 2 + (h)) * HTB)
#define PG8_STAGE(bufoff, gbase, voff) do { _Pragma("unroll") for (int _i = 0; _i < 2; ++_i) \
        __builtin_amdgcn_global_load_lds((const unsigned*)((const char*)(gbase) + (voff)[_i]), (PG8_LAS unsigned*)(lds + (bufoff) + ldsw + _i * 8192), 16, 0, 0); } while (0)
#define PG8_LDA(dst, b, h) do { _Pragma("unroll") for (int m = 0; m < 4; ++m) _Pragma("unroll") for (int k = 0; k < 2; ++k) dst[m][k] = *(const PG8_LAS bf16x8*)(lds + PG8_SA(b, h) + aoff + m * 2048 + k * 1024); } while (0)
#define PG8_LDB(dst, b, h) do { _Pragma("unroll") for (int n = 0; n < 2; ++n) _Pragma("unroll") for (int k = 0; k < 2; ++k) dst[n][k] = *(const PG8_LAS bf16x8*)(lds + PG8_SB(b, h) + boff + n * 2048 + k * 1024); } while (0)
#define PG8_MMA(ai, bj, At, Bt) do { __builtin_amdgcn_s_setprio(1); _Pragma("unroll") for (int m = 0; m < 4; ++m) _Pragma("unroll") for (int n = 0; n < 2; ++n) _Pragma("unroll") for (int k = 0; k < 2; ++k) \
        acc[ai][bj][m][n] = __builtin_amdgcn_mfma_f32_16x16x32_bf16(Bt[n][k], At[m][k], acc[ai][bj][m][n], 0, 0, 0); __builtin_amdgcn_s_setprio(0); } while (0)
#define PG8_WAIT_V(n) asm volatile("s_waitcnt vmcnt(" #n ")" ::: "memory")
#define PG8_WAIT_L(n) asm volatile("s_waitcnt lgkmcnt(" #n ")" ::: "memory")
#define PG8_BAR __builtin_amdgcn_s_barrier()
#define PG8_SCHED __builtin_amdgcn_sched_barrier(0)
    Unit cur, nxt; int ui = 0;
    if (!S.next(0, cur)) return;
    f32x4 acc[2][2][4][2];
#pragma unroll
    for (int a = 0; a < 2; ++a)
#pragma unroll
        for (int b = 0; b < 2; ++b)
#pragma unroll
            for (int m = 0; m < 4; ++m)
#pragma unroll
                for (int n = 0; n < 2; ++n) acc[a][b][m][n] = (f32x4){0.f, 0.f, 0.f, 0.f};
    bf16x8 At[4][2], B0[2][2], B1[2][2];
    const char* cA = (const char*)g.A + (size_t)cur.pm * tstep; const char* cB = (const char*)g.Bt + (size_t)cur.pn * tstep;
    S.a_ready(cur);
    if constexpr (SP2) {
        PG8_STAGE(PG8_SB(0, 0), cB, voffB); PG8_STAGE(PG8_SB(0, 1), cB + hstep, voffB); PG8_STAGE(PG8_SA(0, 0), cA, voffA); PG8_STAGE(PG8_SA(0, 1), cA + hstep, voffA);
        if (wr == 1) PG8_BAR;
        PG8_WAIT_V(2); PG8_BAR;
        PG8_STAGE(PG8_SB(1, 0), cB + kstep, voffB); PG8_STAGE(PG8_SA(1, 0), cA + kstep, voffA); PG8_STAGE(PG8_SB(1, 1), cB + hstep + kstep, voffB);
        PG8_WAIT_V(6); PG8_BAR;
    } else {
        PG8_STAGE(PG8_SB(0, 0), cB, voffB); PG8_STAGE(PG8_SA(0, 0), cA, voffA); PG8_STAGE(PG8_SB(0, 1), cB + hstep, voffB); PG8_STAGE(PG8_SA(0, 1), cA + hstep, voffA);
        if (wr == 1) PG8_BAR;
        PG8_WAIT_V(4); PG8_BAR;
        PG8_STAGE(PG8_SB(1, 0), cB + kstep, voffB); PG8_STAGE(PG8_SA(1, 0), cA + kstep, voffA); PG8_STAGE(PG8_SB(1, 1), cB + hstep + kstep, voffB);
        PG8_WAIT_V(6); PG8_BAR;
    }
    for (;;) {
        const bool has_next = S.next(ui + 1, nxt);
        const char* nA = has_next ? (const char*)g.A + (size_t)nxt.pm * tstep : cA; const char* nB = has_next ? (const char*)g.Bt + (size_t)nxt.pn * tstep : cB;
        for (int t = 0; t < nt; t += 2) {
            const bool last = (t == nt - 2);
            const char* a1 = cA + (size_t)(t + 1) * kstep;
            const char* a2 = last ? nA : cA + (size_t)(t + 2) * kstep; const char* b2 = last ? nB : cB + (size_t)(t + 2) * kstep;
            const char* a3 = a2 + kstep; const char* b3 = b2 + kstep;
            if (last && has_next) S.a_ready(nxt);
            if constexpr (SP2) {
            PG8_LDB(B0, 0, 0); PG8_LDB(B1, 0, 1); PG8_SCHED; PG8_LDA(At, 0, 0); PG8_STAGE(PG8_SA(1, 1), a1 + hstep, voffA);
            PG8_WAIT_V(8); PG8_WAIT_L(0); PG8_BAR; PG8_MMA(0, 0, At, B0); PG8_MMA(0, 1, At, B1); PG8_BAR; PG8_SCHED;
            PG8_LDA(At, 0, 1); PG8_STAGE(PG8_SB(0, 0), b2, voffB); PG8_STAGE(PG8_SB(0, 1), b2 + hstep, voffB); PG8_STAGE(PG8_SA(0, 0), a2, voffA);
            PG8_WAIT_V(8); PG8_WAIT_L(0); PG8_BAR; PG8_MMA(1, 0, At, B0); PG8_MMA(1, 1, At, B1); PG8_BAR; PG8_SCHED;
            PG8_LDB(B0, 1, 0); PG8_LDB(B1, 1, 1); PG8_SCHED; PG8_LDA(At, 1, 0); PG8_STAGE(PG8_SA(0, 1), a2 + hstep, voffA);
            PG8_WAIT_V(8); PG8_WAIT_L(0); PG8_BAR; PG8_MMA(0, 0, At, B0); PG8_MMA(0, 1, At, B1); PG8_BAR; PG8_SCHED;
            PG8_LDA(At, 1, 1); PG8_STAGE(PG8_SB(1, 0), b3, voffB); PG8_STAGE(PG8_SB(1, 1), b3 + hstep, voffB); PG8_STAGE(PG8_SA(1, 0), a3, voffA);
            PG8_WAIT_V(8); PG8_WAIT_L(0); PG8_BAR; PG8_MMA(1, 0, At, B0); PG8_MMA(1, 1, At, B1); PG8_BAR; PG8_SCHED;
            } else {
            PG8_LDB(B0, 0, 0); PG8_SCHED; PG8_LDA(At, 0, 0); PG8_STAGE(PG8_SA(1, 1), a1 + hstep, voffA);
            PG8_WAIT_L(8); PG8_BAR; PG8_WAIT_L(0); PG8_MMA(0, 0, At, B0); PG8_BAR; PG8_SCHED;
            PG8_LDB(B1, 0, 1); PG8_STAGE(PG8_SB(0, 0), b2, voffB);
            PG8_BAR; PG8_WAIT_L(0); PG8_MMA(0, 1, At, B1); PG8_BAR;
            PG8_LDA(At, 0, 1); PG8_STAGE(PG8_SA(0, 0), a2, voffA);
            PG8_BAR; PG8_WAIT_L(0); PG8_MMA(1, 0, At, B0); PG8_BAR; PG8_SCHED;
            PG8_STAGE(PG8_SB(0, 1), b2 + hstep, voffB);
            PG8_WAIT_V(6); PG8_BAR; PG8_MMA(1, 1, At, B1); PG8_BAR;
            PG8_LDB(B0, 1, 0); PG8_SCHED; PG8_LDA(At, 1, 0); PG8_STAGE(PG8_SA(0, 1), a2 + hstep, voffA);
            PG8_WAIT_L(8); PG8_BAR; PG8_WAIT_L(0); PG8_MMA(0, 0, At, B0); PG8_BAR; PG8_SCHED;
            PG8_LDB(B1, 1, 1); PG8_STAGE(PG8_SB(1, 0), b3, voffB);
            PG8_BAR; PG8_WAIT_L(0); PG8_MMA(0, 1, At, B1); PG8_BAR;
            PG8_LDA(At, 1, 1); PG8_STAGE(PG8_SA(1, 0), a3, voffA);
            PG8_BAR; PG8_WAIT_L(0); PG8_MMA(1, 0, At, B0); PG8_BAR; PG8_SCHED;
            PG8_STAGE(PG8_SB(1, 1), b3 + hstep, voffB);
            PG8_WAIT_V(6); PG8_BAR; PG8_MMA(1, 1, At, B1); PG8_BAR;
            }
        }
        if constexpr (ALIGN_EPI) { if (wr == 0) PG8_BAR; }
        if constexpr (!Epi::AFTER_DRAIN) { E(acc, cur, wr, wc, fr, fq); S.done(cur); }
        if (!has_next) break;
#pragma unroll
        for (int a = 0; a < 2; ++a)
#pragma unroll
            for (int b = 0; b < 2; ++b)
#pragma unroll
                for (int m = 0; m < 4; ++m)
#pragma unroll
                    for (int n = 0; n < 2; ++n) acc[a][b][m][n] = (f32x4){0.f, 0.f, 0.f, 0.f};
        cur = nxt; cA = nA; cB = nB; ++ui;
        if constexpr (ALIGN_EPI) { if (wr == 1) PG8_BAR; }
    }
    PG8_WAIT_V(0);
    if constexpr (!ALIGN_EPI) { if (wr == 0) PG8_BAR; }
    PG8_BAR;
    if constexpr (Epi::AFTER_DRAIN) { E.fused(acc, cur, wr, wc, fr, fq, lds, wid, lane); S.done(cur); }
#undef PG8_SA
#undef PG8_SB
#undef PG8_STAGE
#undef PG8_LDA
#undef PG8_LDB
#undef PG8_MMA
#undef PG8_WAIT_V
#undef PG8_WAIT_L
#undef PG8_BAR
#undef PG8_SCHED
}
}
constexpr int DM = 1024, NB = 2, SEQ = 8192, DEPTH = 2, DECB = 128, PAST = 2048, PAGE = 128, NPG = 16, NPOOLPG = 2560;
constexpr int MP = NB * SEQ;
constexpr int MTOT = MP + 256;
constexpr int MLN = MP + DECB;
constexpr int DIN = 3328;
constexpr float LN_EPS = 1e-5f, ALPHA = 1.4142135623730951f, LOG2E = 1.4426950408889634f;
constexpr size_t O_YP = 0, O_YS = O_YP + (size_t)MP * DM, O_CAP = O_YS + (size_t)DECB * DM, O_CAS = O_CAP + (size_t)DEPTH * NB * 2 * 256,
                 O_CBP = O_CAS + (size_t)DEPTH * DECB * 2 * 256, O_CBS = O_CBP + (size_t)DEPTH * NB * 30 * 256, O_PLP = O_CBS + (size_t)DEPTH * DECB * 30 * 256,
                 O_PLS = O_PLP + (size_t)DEPTH * NB * 15 * 256, O_KP = O_PLS + (size_t)DEPTH * DECB * 15 * 256, O_VP = O_KP + (size_t)DEPTH * MP * 256,
                 O_KS = O_VP + (size_t)DEPTH * MP * 256, O_VS = O_KS + (size_t)DEPTH * DECB * 256, O_END = O_VS + (size_t)DEPTH * DECB * 256;
static_assert(O_END == 36944896, "output size");
constexpr size_t MiB = 1u << 20;
constexpr size_t WS_CTL = 0, CTL_ZERO_BYTES = 1 * MiB;
constexpr size_t WS_WINT = 2 * MiB;
constexpr size_t WS_WOUTT = 16 * MiB;
constexpr size_t WS_XB = 32 * MiB;
constexpr size_t WS_MIX = 66 * MiB;
constexpr size_t WS_Q = 100 * MiB, WS_KT = 108 * MiB, WS_VT = 116 * MiB;
constexpr size_t WS_U = 128 * MiB;
constexpr size_t WS_PRE = 236 * MiB;
constexpr size_t WS_XF = 304 * MiB;
constexpr size_t WS_END = 370 * MiB;
static_assert(WS_WINT + (size_t)DEPTH * DIN * DM * 2 <= WS_WOUTT && WS_WOUTT + (size_t)DEPTH * DM * DM * 2 <= WS_XB && WS_XB + (size_t)MTOT * DM * 2 <= WS_MIX &&
              WS_MIX + (size_t)MTOT * DM * 2 <= WS_Q && WS_U + (size_t)MTOT * DIN * 2 <= WS_PRE && WS_PRE + (size_t)MLN * DM * 4 <= WS_XF && WS_XF + (size_t)MLN * DM * 4 <= WS_END, "d_ws map");
constexpr int CW_BAR = 4096;
constexpr int NWAVES = 8;
constexpr int RING_OFF = 0, RING_BYTES = 131072;
constexpr int LDSCTL_OFF = RING_BYTES, MISC_OFF = LDSCTL_OFF + 320;
constexpr int LDS_BYTES = 147456;
#define GAS __attribute__((address_space(1)))
#define LAS __attribute__((address_space(3)))
typedef unsigned short bf16;
typedef unsigned v4u __attribute__((ext_vector_type(4)));
typedef float f32x4 __attribute__((ext_vector_type(4)));
typedef short bf16x8 __attribute__((ext_vector_type(8)));
typedef unsigned u32x4 __attribute__((ext_vector_type(4)));
typedef GAS unsigned gu32;
typedef GAS unsigned long long gu64;
#define RLX_AGENT __ATOMIC_RELAXED, __HIP_MEMORY_SCOPE_AGENT
#define LDS_WAIT() asm volatile("s_waitcnt lgkmcnt(0)" ::: "memory")
#define VM_WAIT() asm volatile("s_waitcnt vmcnt(0)" ::: "memory")
__device__ __forceinline__ unsigned long long rt() { return __builtin_amdgcn_s_memrealtime(); }
__device__ __forceinline__ unsigned f2bf(float f) { unsigned u = __builtin_bit_cast(unsigned, f); return (u + 0x7fffu + ((u >> 16) & 1u)) >> 16; }
__device__ __forceinline__ unsigned pk2(float lo, float hi) { return f2bf(lo) | (f2bf(hi) << 16); }
#define XB_TMO      128
#define XB_XCNT(j)  (256  + 64 * (j))
#define XB_XSUB(j)  (1280 + 64 * (j))
#define XB_XGEN(j)  (2304 + 64 * (j))
#define XB_TOP      3328
#define XB_TOPGEN   3392
#define XCD_BAR_WORDS 3456
#define XB_SPIN_CAP (1u << 18)

__device__ __forceinline__ unsigned xb_ld(unsigned* p)              { return __hip_atomic_load(p, __ATOMIC_RELAXED, __HIP_MEMORY_SCOPE_AGENT); }
__device__ __forceinline__ unsigned xb_add(unsigned* p, unsigned v) { return __hip_atomic_fetch_add(p, v, __ATOMIC_RELAXED, __HIP_MEMORY_SCOPE_AGENT); }
__device__ __forceinline__ unsigned xb_xcc_id() { return (unsigned)__builtin_amdgcn_s_getreg((3 << 11) | 20) & 0xFu; }
#define XB_SPIN(cond, bar) do { unsigned _sp = 0; while (cond) { __builtin_amdgcn_s_sleep(1); \
    if ((++_sp & 255u) == 0u) { if (xb_ld(&(bar)[XB_TMO])) break; if (_sp > XB_SPIN_CAP) { atomicAdd(&(bar)[XB_TMO], 1u); break; } } } } while (0)

struct XcdBarrier {
    unsigned* bar; unsigned x;
    volatile LAS unsigned* st;
};

__device__ __forceinline__ XcdBarrier xcd_barrier_post(unsigned* bar, volatile LAS unsigned* st) {
    XcdBarrier b; b.bar = bar; b.x = xb_xcc_id(); b.st = st;
    if (threadIdx.x == 0) (void)xb_add(&bar[XB_XCNT(b.x)], 1u);
    return b;
}
__device__ __forceinline__ void xcd_barrier_complete(unsigned* bar, unsigned x, unsigned& nloc, unsigned& nx) {
    const unsigned G = gridDim.x * gridDim.y * gridDim.z;
    unsigned sum, cnt, mine, sp = 0u;
    for (;;) {
        sum = 0u; cnt = 0u; mine = 0u;
#pragma unroll
        for (unsigned j = 0; j < 16; ++j) { const unsigned c = xb_ld(&bar[XB_XCNT(j)]); sum += c; cnt += (c > 0u) ? 1u : 0u; mine = (j == x) ? c : mine; }
        if (sum == G) break;
        __builtin_amdgcn_s_sleep(1);
        if ((++sp & 255u) == 0u) { if (xb_ld(&bar[XB_TMO])) break; if (sp > XB_SPIN_CAP) { atomicAdd(&bar[XB_TMO], 1u); break; } }
    }
    nloc = mine > 0u ? mine : 1u; nx = cnt > 0u ? cnt : 1u;
}

__device__ __forceinline__ void xcd_barrier(const XcdBarrier& b) {
    asm volatile("s_waitcnt vmcnt(0)" ::: "memory");
    __syncthreads();
    if (threadIdx.x == 0) {
        unsigned* bar = b.bar;
        __builtin_amdgcn_s_waitcnt(0);
        unsigned nloc = b.st[0], nx = b.st[1];
        if (nloc == 0u) { xcd_barrier_complete(bar, b.x, nloc, nx); b.st[0] = nloc; b.st[1] = nx; }
        const unsigned old = xb_add(&bar[XB_XSUB(b.x)], 1u);
        const unsigned gen = old / nloc;
        if (old + 1u == (gen + 1u) * nloc) {
            __builtin_amdgcn_fence(__ATOMIC_RELEASE, "agent");
            asm volatile("s_waitcnt vmcnt(0)" ::: "memory");
            const unsigned og = xb_add(&bar[XB_TOP], 1u);
            const unsigned tg = og / nx;
            if (og + 1u == (tg + 1u) * nx) xb_add(&bar[XB_TOPGEN], 1u);
            else XB_SPIN(xb_ld(&bar[XB_TOPGEN]) == tg, bar);
            __builtin_amdgcn_fence(__ATOMIC_ACQUIRE, "agent");
            xb_add(&bar[XB_XGEN(b.x)], 1u);
            asm volatile("s_waitcnt vmcnt(0)" ::: "memory");
        } else {
            XB_SPIN(xb_ld(&bar[XB_XGEN(b.x)]) == gen, bar);
            __builtin_amdgcn_fence(__ATOMIC_ACQUIRE, "agent");
            asm volatile("s_waitcnt vmcnt(0)" ::: "memory");
        }
    }
    __syncthreads();
}
__device__ __forceinline__ float wave_sum(float v) {
#pragma unroll
    for (int o = 1; o < 64; o <<= 1) v += __shfl_xor(v, o);
    return v;
}
__device__ __forceinline__ void p0_transpose_item(const float* W, int K, int N, bf16* WT, int row_off, LAS float* scr, int item, int lane) {
    const int nblk = N / 32, kb = item / nblk, nb = item % nblk, k0 = 64 * kb, n0 = 32 * nb;
#pragma unroll 8
    for (int i = 0; i < 32; ++i) { const int kk = 2 * i + (lane >> 5); scr[kk * 33 + (lane & 31)] = W[(size_t)(k0 + kk) * N + n0 + (lane & 31)]; }
    LDS_WAIT(); asm volatile("" ::: "memory");
    const int c = lane & 7;
#pragma unroll
    for (int j = 0; j < 4; ++j) { const int n = (lane >> 3) + 8 * j; const LAS float* s = scr + (8 * c) * 33 + n;
        v4u o; o.x = pk2(s[0 * 33], s[1 * 33]); o.y = pk2(s[2 * 33], s[3 * 33]); o.z = pk2(s[4 * 33], s[5 * 33]); o.w = pk2(s[6 * 33], s[7 * 33]);
        *(GAS v4u*)(WT + (size_t)(row_off + n0 + n) * K + k0 + 8 * c) = o; }
    LDS_WAIT(); asm volatile("" ::: "memory");
}
__device__ __forceinline__ float bf2f(unsigned short v) { return __uint_as_float((unsigned)v << 16); }
__device__ __forceinline__ float bflo(unsigned v) { return __uint_as_float(v << 16); }
__device__ __forceinline__ float bfhi(unsigned v) { return __uint_as_float(v & 0xffff0000u); }
__device__ __forceinline__ float ex2(float x) { return __builtin_amdgcn_exp2f(x); }
__device__ __forceinline__ float lg2(float x) { return __builtin_amdgcn_logf(x); }
__device__ __forceinline__ float sigmoidf_(float x) { return 1.0f / (1.0f + ex2(-x * LOG2E)); }
__device__ __forceinline__ float siluf_(float x) { return x * sigmoidf_(x); }

struct Args { const float* in[20]; float* out; unsigned char* ws; };
#define WSP(T, off) ((T*)(A.ws + (off)))
typedef __attribute__((address_space(4))) const Args CArgs;
#define KARGS ((CArgs*)__builtin_amdgcn_kernarg_segment_ptr())
#define KIN(k) (*(const float* const volatile __attribute__((address_space(4)))*)&KARGS->in[k])
#define KOUT (*(float* const volatile __attribute__((address_space(4)))*)&KARGS->out)
#define KWS (*(unsigned char* const volatile __attribute__((address_space(4)))*)&KARGS->ws)
#define ARGS_BEGIN Args A; A.ws = KWS; A.out = KOUT
#define ARG(k) A.in[k] = KIN(k)
struct Frame {
    LAS unsigned char* lds;
    volatile LAS unsigned* MISC;
    gu32* ctl;
    int tid, lane, wave, vcu, G;
};
enum { I_XP = 0, I_XS, I_CK, I_CV, I_PT, I_SCA, I_SCB, I_SPL, I_WIN, I_CAW, I_CBW, I_CBB, I_NBG, I_NBB, I_PW, I_PS, I_WOUT, I_LNG, I_LNB, I_SBB };

__device__ __forceinline__ void row_to_bf16(const float* xrow, bf16* orow, int lane) {
    const GAS f32x4* xr = (const GAS f32x4*)xrow + lane;
    GAS unsigned long long* o8 = (GAS unsigned long long*)orow + lane;
#pragma unroll
    for (int j = 0; j < 4; ++j) { const f32x4 v = xr[64 * j]; o8[64 * j] = (unsigned long long)pk2(v.x, v.y) | ((unsigned long long)pk2(v.z, v.w) << 32); }
}
__device__ __forceinline__ void prologue(Frame& F) {
    int tid_l = F.tid; asm volatile("" : "+v"(tid_l)); const int lane_l = tid_l & 63;
    ARGS_BEGIN; ARG(I_WIN); ARG(I_WOUT); ARG(I_XP); ARG(I_XS);
    LAS float* scr = (LAS float*)(F.lds + RING_OFF + F.wave * 16384);
    const int gw = F.vcu * NWAVES + F.wave, NGW = F.G * NWAVES;
    constexpr int I_IN = (DM / 64) * (DIN / 32), I_OUT = (DM / 64) * (DM / 32);
    constexpr int NITEMS = DEPTH * (I_IN + I_OUT);
    for (int it = gw; it < NITEMS; it += NGW) {
        int r = it; const int l = r / (I_IN + I_OUT); r -= l * (I_IN + I_OUT);
        if (r < I_IN) p0_transpose_item(A.in[I_WIN] + (size_t)l * DM * DIN, DM, DIN, WSP(bf16, WS_WINT) + (size_t)l * DIN * DM, 0, scr, r, lane_l);
        else p0_transpose_item(A.in[I_WOUT] + (size_t)l * DM * DM, DM, DM, WSP(bf16, WS_WOUTT) + (size_t)l * DM * DM, 0, scr, r - I_IN, lane_l);
    }
    for (int m = gw; m < MTOT; m += NGW) {
        if (m < MP) row_to_bf16(A.in[I_XP] + (size_t)m * DM, WSP(bf16, WS_XB) + (size_t)m * DM, lane_l);
        else if (m < MP + DECB) row_to_bf16(A.in[I_XS] + (size_t)(m - MP) * DM, WSP(bf16, WS_XB) + (size_t)m * DM, lane_l);
        else { GAS unsigned long long* o8 = (GAS unsigned long long*)(WSP(bf16, WS_XB) + (size_t)m * DM) + lane_l;
#pragma unroll
            for (int j = 0; j < 4; ++j) o8[64 * j] = 0ull; }
    }
}

__device__ __forceinline__ void mixer_unit(Frame& F, int l, int unit) {
    int tid_l = F.tid; asm volatile("" : "+v"(tid_l)); const int lane_l = tid_l & 63;
    ARGS_BEGIN; ARG(I_CBW); ARG(I_CBB); ARG(I_NBG); ARG(I_NBB); ARG(I_CAW); ARG(I_PW); ARG(I_PS);
    const int b = unit >> 8, t0 = (unit & 255) * 32, c = tid_l & 255, half = tid_l >> 8;
    LAS float* G = (LAS float*)(F.lds);
    LAS float* BC = (LAS float*)(F.lds + 63488);
    LAS float* DIFF = (LAS float*)(F.lds + 96256);
    LAS float* CV = G;
    const bf16* Ub = WSP(bf16, WS_U) + (size_t)b * SEQ * DIN;
    float* out = A.out;
#pragma unroll 1
    for (int gr = half; gr < 62; gr += 2) { const int t = t0 - 30 + gr; float v = 0.f;
        if (t >= 0) { const bf16* ur = Ub + (size_t)t * DIN; v = bf2f(ur[1024 + c]) * sigmoidf_(bf2f(ur[1280 + c])); }
        G[gr * 256 + c] = v; }
    __syncthreads();
    if (t0 == SEQ - 32) for (int k = half; k < 30; k += 2) out[O_CBP + ((size_t)(l * NB + b) * 30 + k) * 256 + c] = G[(k + 32) * 256 + c];
    { const float* wbp = A.in[I_CBW] + (size_t)l * 31 * 256 + c;
      const float bias = A.in[I_CBB][l * 256 + c];
#pragma unroll 1
      for (int r = 0; r < 16; ++r) { const int tt = half * 16 + r; float s = bias;
#pragma unroll 4
          for (int k = 0; k < 31; ++k) s += wbp[k * 256] * G[(tt + k) * 256 + c];
          BC[tt * 256 + c] = s; } }
    __syncthreads();
#pragma unroll 1
    for (int rr = 0; rr < 4; ++rr) { const int tt = F.wave * 4 + rr; float x[4]; float s = 0.f;
#pragma unroll
        for (int j = 0; j < 4; ++j) { x[j] = BC[tt * 256 + lane_l + 64 * j]; s += x[j]; }
        const float mean = wave_sum(s) * (1.f / 256.f); float q = 0.f;
#pragma unroll
        for (int j = 0; j < 4; ++j) { x[j] -= mean; q += x[j] * x[j]; }
        const float rstd = 1.0f / sqrtf(wave_sum(q) * (1.f / 256.f) + LN_EPS);
        const bf16* ur = Ub + (size_t)(t0 + tt) * DIN; bf16* mr = WSP(bf16, WS_MIX) + ((size_t)b * SEQ + t0 + tt) * DM;
#pragma unroll
        for (int j = 0; j < 4; ++j) { const int cc = lane_l + 64 * j; const float y = x[j] * rstd * A.in[I_NBG][l * 256 + cc] + A.in[I_NBB][l * 256 + cc];
            mr[256 + cc] = (bf16)f2bf(siluf_(y) * siluf_(bf2f(ur[1536 + cc]))); } }
    { const float w0 = A.in[I_CAW][(l * 3 + 0) * 256 + c], w1 = A.in[I_CAW][(l * 3 + 1) * 256 + c], w2 = A.in[I_CAW][(l * 3 + 2) * 256 + c];
      const int ts = t0 + half * 16; float p2 = 0.f, p1 = 0.f;
      if (ts - 2 >= 0) { const bf16* ur = Ub + (size_t)(ts - 2) * DIN; p2 = bf2f(ur[512 + c]) * bf2f(ur[c]); }
      if (ts - 1 >= 0) { const bf16* ur = Ub + (size_t)(ts - 1) * DIN; p1 = bf2f(ur[512 + c]) * bf2f(ur[c]); }
#pragma unroll 1
      for (int r = 0; r < 16; ++r) { const int t = ts + r; const bf16* ur = Ub + (size_t)t * DIN;
          const float cur = bf2f(ur[512 + c]) * bf2f(ur[c]); const float cv = w0 * p2 + w1 * p1 + w2 * cur;
          WSP(bf16, WS_MIX)[((size_t)b * SEQ + t) * DM + c] = (bf16)f2bf(bf2f(ur[256 + c]) * cv * siluf_(bf2f(ur[768 + c])));
          p2 = p1; p1 = cur; }
      if (t0 == SEQ - 32 && half == 1) { out[O_CAP + ((size_t)(l * NB + b) * 2 + 0) * 256 + c] = p2; out[O_CAP + ((size_t)(l * NB + b) * 2 + 1) * 256 + c] = p1; } }
    __syncthreads();
#pragma unroll 1
    for (int cr = half; cr < 47; cr += 2) { const int t = t0 - 15 + cr; float v = 0.f; if (t >= 0) v = bf2f(Ub[(size_t)t * DIN + 1792 + c]); CV[cr * 256 + c] = v; }
    __syncthreads();
    if (t0 == SEQ - 32) for (int k = half; k < 15; k += 2) out[O_PLP + ((size_t)(l * NB + b) * 15 + k) * 256 + c] = CV[(k + 32) * 256 + c];
    { const int g = c >> 6, w = 2 << g;
#pragma unroll 1
      for (int r = 0; r < 16; ++r) { const int tt = half * 16 + r, t = t0 + tt; float win = 0.f;
#pragma unroll 1
          for (int k = 0; k < w; ++k) win += CV[(tt + 15 - k) * 256 + c];
          const int cnt = (t + 1 < w) ? t + 1 : w;
          DIFF[tt * 256 + c] = win / (float)cnt - CV[(tt + 15) * 256 + c]; } }
    __syncthreads();
    { const int g = c >> 6, d = c & 63; const float* pwp = A.in[I_PW] + ((size_t)(l * 4 + g) * 64) * 64 + d;
      const float ps = A.in[I_PS][l * 256 + c];
#pragma unroll 1
      for (int r = 0; r < 16; ++r) { const int tt = half * 16 + r, t = t0 + tt; float y = 0.f;
#pragma unroll 4
          for (int cc = 0; cc < 64; ++cc) y += DIFF[tt * 256 + g * 64 + cc] * pwp[cc * 64];
          WSP(bf16, WS_MIX)[((size_t)b * SEQ + t) * DM + 512 + c] = (bf16)f2bf(y * ps * siluf_(bf2f(Ub[(size_t)t * DIN + 2048 + c]))); } }
    __syncthreads();
}

__device__ __forceinline__ void sample_mixer_unit(Frame& F, int l, int i) {
    int tid_l = F.tid; asm volatile("" : "+v"(tid_l)); const int lane_l = tid_l & 63;
    ARGS_BEGIN; ARG(I_SCA); ARG(I_SCB); ARG(I_SPL); ARG(I_CBW); ARG(I_CBB); ARG(I_NBG); ARG(I_NBB); ARG(I_CAW); ARG(I_PW); ARG(I_PS);
    LAS float* red = (LAS float*)(F.lds);
    LAS float* DIFF = (LAS float*)(F.lds + 1024);
    const int c = tid_l & 255; const bool act = tid_l < 256;
    const bf16* ur = WSP(bf16, WS_U) + (size_t)(MP + i) * DIN; bf16* mr = WSP(bf16, WS_MIX) + (size_t)(MP + i) * DM; float* out = A.out;
    float bc = 0.f;
    if (act) {
        const float* ha = A.in[I_SCA] + ((size_t)(l * DECB + i) * 2) * 256;
        const float ah = bf2f(ur[512 + c]) * bf2f(ur[c]);
        const float cv = A.in[I_CAW][(l * 3 + 0) * 256 + c] * ha[c] + A.in[I_CAW][(l * 3 + 1) * 256 + c] * ha[256 + c] + A.in[I_CAW][(l * 3 + 2) * 256 + c] * ah;
        mr[c] = (bf16)f2bf(bf2f(ur[256 + c]) * cv * siluf_(bf2f(ur[768 + c])));
        out[O_CAS + ((size_t)(l * DECB + i) * 2 + 0) * 256 + c] = ha[256 + c]; out[O_CAS + ((size_t)(l * DECB + i) * 2 + 1) * 256 + c] = ah;
        const float* hb = A.in[I_SCB] + ((size_t)(l * DECB + i) * 30) * 256;
        const float glu = bf2f(ur[1024 + c]) * sigmoidf_(bf2f(ur[1280 + c]));
        bc = A.in[I_CBB][l * 256 + c] + A.in[I_CBW][(l * 31 + 30) * 256 + c] * glu;
        float* ob = out + O_CBS + ((size_t)(l * DECB + i) * 30) * 256;
#pragma unroll 2
        for (int k = 0; k < 30; ++k) { const float h = hb[k * 256 + c]; bc += A.in[I_CBW][(l * 31 + k) * 256 + c] * h; if (k >= 1) ob[(k - 1) * 256 + c] = h; }
        ob[29 * 256 + c] = glu;
    }
    float s = act ? bc : 0.f; s = wave_sum(s); if (lane_l == 0) red[F.wave] = s;
    __syncthreads();
    const float mean = (red[0] + red[1] + red[2] + red[3]) * (1.f / 256.f);
    const float dv = bc - mean; float q = act ? dv * dv : 0.f; q = wave_sum(q); if (lane_l == 0) red[8 + F.wave] = q;
    __syncthreads();
    const float rstd = 1.0f / sqrtf((red[8] + red[9] + red[10] + red[11]) * (1.f / 256.f) + LN_EPS);
    if (act) {
        const float y = dv * rstd * A.in[I_NBG][l * 256 + c] + A.in[I_NBB][l * 256 + c];
        mr[256 + c] = (bf16)f2bf(siluf_(y) * siluf_(bf2f(ur[1536 + c])));
        const float* hc = A.in[I_SPL] + ((size_t)(l * DECB + i) * 15) * 256;
        const float cvv = bf2f(ur[1792 + c]); const int g = c >> 6, w = 2 << g; float win = cvv;
        float* op = out + O_PLS + ((size_t)(l * DECB + i) * 15) * 256;
#pragma unroll 1
        for (int k = 0; k < 15; ++k) { const float h = hc[k * 256 + c]; if (k >= 15 - (w - 1)) win += h; if (k >= 1) op[(k - 1) * 256 + c] = h; }
        op[14 * 256 + c] = cvv;
        DIFF[c] = win / (float)w - cvv;
    }
    __syncthreads();
    if (act) { const int g = c >> 6, d = c & 63; float y = 0.f;
#pragma unroll 4
        for (int cc = 0; cc < 64; ++cc) y += DIFF[g * 64 + cc] * A.in[I_PW][((size_t)(l * 4 + g) * 64 + cc) * 64 + d];
        mr[512 + c] = (bf16)f2bf(y * A.in[I_PS][l * 256 + c] * siluf_(bf2f(ur[2048 + c]))); }
    __syncthreads();
}

__device__ __forceinline__ void attn_naive(Frame& F, int l) {
    int tid_l = F.tid; asm volatile("" : "+v"(tid_l)); const int lane_l = tid_l & 63;
    ARGS_BEGIN; ARG(I_SBB);
    const int gw = F.vcu * NWAVES + F.wave, NGW = F.G * NWAVES, lane = lane_l;
    for (int idx = gw; idx < 4 * MP; idx += NGW) {
        const int bh = idx >> 13, t = idx & 8191, b = bh >> 2, h = bh & 3;
        const float bias2 = A.in[I_SBB][l * 4 + h] * LOG2E;
        float qf[64];
        { const u32x4* qp = (const u32x4*)(WSP(bf16, WS_Q) + ((size_t)bh * SEQ + t) * 64);
#pragma unroll
          for (int cch = 0; cch < 8; ++cch) { const u32x4 v = qp[cch];
              qf[8 * cch + 0] = bflo(v.x); qf[8 * cch + 1] = bfhi(v.x); qf[8 * cch + 2] = bflo(v.y); qf[8 * cch + 3] = bfhi(v.y);
              qf[8 * cch + 4] = bflo(v.z); qf[8 * cch + 5] = bfhi(v.z); qf[8 * cch + 6] = bflo(v.w); qf[8 * cch + 7] = bfhi(v.w); } }
        const bf16* Kb = WSP(bf16, WS_KT) + (size_t)bh * 524288; const bf16* Vb = WSP(bf16, WS_VT) + (size_t)bh * 524288;
        float L = 0.f, o = 0.f;
        for (int j = (t - 1) >> 6; j >= 0 && t > 0; --j) {
            const int s = 64 * j + lane; float z = 0.f;
#pragma unroll
            for (int cch = 0; cch < 8; ++cch) { const u32x4 v = *(const u32x4*)(Kb + (size_t)j * 4096 + cch * 512 + lane * 8);
                z += qf[8 * cch + 0] * bflo(v.x) + qf[8 * cch + 1] * bfhi(v.x) + qf[8 * cch + 2] * bflo(v.y) + qf[8 * cch + 3] * bfhi(v.y)
                   + qf[8 * cch + 4] * bflo(v.z) + qf[8 * cch + 5] * bfhi(v.z) + qf[8 * cch + 6] * bflo(v.w) + qf[8 * cch + 7] * bfhi(v.w); }
            const bool valid = s < t; const float z2 = fminf(z + bias2, 100.f);
            const float lk = valid ? -lg2(1.0f + ex2(z2)) : 0.f;
            float sfx = lk;
#pragma unroll
            for (int dl = 1; dl < 64; dl <<= 1) { const float y = __shfl_down(sfx, dl); if (lane + dl < 64) sfx += y; }
            const float a = valid ? ex2(z2 + sfx + L) : 0.f;
            L += __shfl(sfx, 0);
            const bf16* vt = Vb + (size_t)j * 4096 + (lane >> 5) * 2048 + ((lane >> 3) & 3) * 8 + (lane & 7);
#pragma unroll
            for (int s2 = 0; s2 < 64; ++s2) { const float as = __uint_as_float(__builtin_amdgcn_readlane(__float_as_uint(a), s2)); o += as * bf2f(vt[(s2 >> 4) * 512 + (s2 & 15) * 32]); }
        }
        const size_t row = (size_t)b * SEQ + t;
        WSP(bf16, WS_MIX)[row * DM + 768 + h * 64 + lane] = (bf16)f2bf(o * siluf_(bf2f(WSP(bf16, WS_U)[row * DIN + 3072 + h * 64 + lane])));
    }
}

__device__ __forceinline__ void sample_attn_unit(Frame& F, int l, int i) {
    int tid_l = F.tid; asm volatile("" : "+v"(tid_l)); const int lane_l = tid_l & 63;
    ARGS_BEGIN; ARG(I_SBB); ARG(I_PT); ARG(I_CK); ARG(I_CV);
    LAS float* sAcc = (LAS float*)(F.lds);
    LAS float* sL = (LAS float*)(F.lds + 8192);
    const int lane = lane_l, h = lane >> 4, w = F.wave;
    const bf16* ur = WSP(bf16, WS_U) + (size_t)(MP + i) * DIN;
    float q4[4];
    { const unsigned long long qq = *(const unsigned long long*)(ur + 2304 + lane * 4); q4[0] = bflo((unsigned)qq); q4[1] = bfhi((unsigned)qq); q4[2] = bflo((unsigned)(qq >> 32)); q4[3] = bfhi((unsigned)(qq >> 32)); }
    const float bias2 = A.in[I_SBB][l * 4 + h] * LOG2E;
    const int* pt = (const int*)A.in[I_PT] + i * NPG;
    f32x4 acc = {0.f, 0.f, 0.f, 0.f}; float Lrun = 0.f;
#pragma unroll 1
    for (int pg = 1; pg >= 0; --pg) {
        const int page = pt[2 * w + pg];
        const float* kb = A.in[I_CK] + ((size_t)(l * NPOOLPG + page) * PAGE) * 256 + lane * 4;
        const float* vb = A.in[I_CV] + ((size_t)(l * NPOOLPG + page) * PAGE) * 256 + lane * 4;
#pragma unroll 1
        for (int r0 = PAGE - 8; r0 >= 0; r0 -= 8) {
            f32x4 k4[8], v4[8];
#pragma unroll
            for (int jj = 0; jj < 8; ++jj) { k4[jj] = *(const f32x4*)(kb + (size_t)(r0 + jj) * 256); v4[jj] = *(const f32x4*)(vb + (size_t)(r0 + jj) * 256); }
#pragma unroll
            for (int jj = 7; jj >= 0; --jj) {
                float p = q4[0] * k4[jj].x + q4[1] * k4[jj].y + q4[2] * k4[jj].z + q4[3] * k4[jj].w;
                p += __shfl_xor(p, 1); p += __shfl_xor(p, 2); p += __shfl_xor(p, 4); p += __shfl_xor(p, 8);
                const float z2 = fminf(p + bias2, 100.f); const float lk = -lg2(1.0f + ex2(z2)); const float a = ex2(z2 + lk + Lrun); Lrun += lk;
                acc = acc + v4[jj] * a;
            }
        }
    }
    *(LAS f32x4*)(sAcc + w * 256 + lane * 4) = acc; if ((lane & 15) == 0) sL[w * 4 + h] = Lrun;
    __syncthreads();
    if (tid_l < 256) { const int hh = tid_l >> 6; float o = 0.f, Ls = 0.f;
#pragma unroll 1
        for (int ww = 7; ww >= 0; --ww) { o += ex2(Ls) * sAcc[ww * 256 + tid_l]; Ls += sL[ww * 4 + hh]; }
        WSP(bf16, WS_MIX)[(size_t)(MP + i) * DM + 768 + tid_l] = (bf16)f2bf(o * siluf_(bf2f(ur[3072 + tid_l]))); }
    __syncthreads();
}

__device__ __forceinline__ void sample_outproj(Frame& F, int l) {
    int tid_l = F.tid; asm volatile("" : "+v"(tid_l)); const int lane_l = tid_l & 63;
    ARGS_BEGIN; ARG(I_XS);
    const float* base = (l == 0) ? A.in[I_XS] : WSP(float, WS_XF) + (size_t)MP * DM;
    const bf16* W = WSP(bf16, WS_WOUTT) + (size_t)l * DM * DM;
    for (int o = F.vcu * 512 + tid_l; o < DECB * DM; o += F.G * 512) { const int i = o >> 10, col = o & 1023;
        const u32x4* a = (const u32x4*)(WSP(bf16, WS_MIX) + (size_t)(MP + i) * DM); const u32x4* wv = (const u32x4*)(W + (size_t)col * DM); float s = 0.f;
        for (int k = 0; k < DM / 8; ++k) { const u32x4 x = a[k], y = wv[k];
            s += bflo(x.x) * bflo(y.x) + bfhi(x.x) * bfhi(y.x) + bflo(x.y) * bflo(y.y) + bfhi(x.y) * bfhi(y.y) + bflo(x.z) * bflo(y.z) + bfhi(x.z) * bfhi(y.z) + bflo(x.w) * bflo(y.w) + bfhi(x.w) * bfhi(y.w); }
        WSP(float, WS_PRE)[(size_t)(MP + i) * DM + col] = ALPHA * base[(size_t)i * DM + col] + s; }
}

__device__ __forceinline__ void ln_rows(Frame& F, int l) {
    int tid_l = F.tid; asm volatile("" : "+v"(tid_l)); const int lane_l = tid_l & 63;
    ARGS_BEGIN; ARG(I_LNG); ARG(I_LNB);
    const int gw = F.vcu * NWAVES + F.wave, NGW = F.G * NWAVES, lane = lane_l;
    const float* g = A.in[I_LNG] + l * DM; const float* bb = A.in[I_LNB] + l * DM;
    for (int m = gw; m < MLN; m += NGW) {
        const f32x4* xr = (const f32x4*)(WSP(float, WS_PRE) + (size_t)m * DM) + lane; f32x4 v[4]; float s = 0.f;
#pragma unroll
        for (int j = 0; j < 4; ++j) { v[j] = xr[64 * j]; s += (v[j].x + v[j].y) + (v[j].z + v[j].w); }
        const float mean = wave_sum(s) * (1.f / DM); float s2 = 0.f;
#pragma unroll
        for (int j = 0; j < 4; ++j) { v[j] = v[j] - mean; s2 += (v[j].x * v[j].x + v[j].y * v[j].y) + (v[j].z * v[j].z + v[j].w * v[j].w); }
        const float rstd = 1.f / sqrtf(wave_sum(s2) * (1.f / DM) + LN_EPS);
        float* dst = (l == DEPTH - 1) ? (m < MP ? A.out + O_YP + (size_t)m * DM : A.out + O_YS + (size_t)(m - MP) * DM) : WSP(float, WS_XF) + (size_t)m * DM;
        unsigned long long* o8 = (unsigned long long*)(WSP(bf16, WS_XB) + (size_t)m * DM) + lane;
#pragma unroll
        for (int j = 0; j < 4; ++j) { const f32x4 gg = ((const f32x4*)g)[64 * j + lane], bv = ((const f32x4*)bb)[64 * j + lane];
            const f32x4 y = v[j] * rstd * gg + bv; ((f32x4*)dst)[64 * j + lane] = y;
            o8[64 * j] = (unsigned long long)pk2(y.x, y.y) | ((unsigned long long)pk2(y.z, y.w) << 32); }
    }
}
__global__ void __launch_bounds__(NWAVES * 64, 2) fwd_kernel(Args args) {
    extern __shared__ __attribute__((aligned(16))) unsigned char lds[];
    Frame F;
    F.lds = (LAS unsigned char*)lds;
    F.MISC = (volatile LAS unsigned*)(F.lds + MISC_OFF);
    F.tid = threadIdx.x; F.lane = F.tid & 63; F.wave = __builtin_amdgcn_readfirstlane(F.tid >> 6);
    F.G = gridDim.x; { const int bx = blockIdx.x; F.vcu = (F.G % 8 == 0) ? (bx % 8) * (F.G / 8) + bx / 8 : bx; }
    F.ctl = (gu32*)(KWS + WS_CTL);
    for (int u = F.tid; u < (LDS_BYTES - LDSCTL_OFF) / 4; u += NWAVES * 64) ((LAS unsigned*)(F.lds + LDSCTL_OFF))[u] = 0u;
    __syncthreads();
    XcdBarrier bar = xcd_barrier_post((unsigned*)(F.ctl + CW_BAR), F.MISC + 8);

#ifndef SK_PRO
    prologue(F);
#endif
    xcd_barrier(bar);
#pragma unroll
    for (int l = 0; l < DEPTH; ++l) {
#ifndef SK_P1
        { ARGS_BEGIN; pg8::Gemm g{WSP(bf16, WS_XB), WSP(bf16, WS_WINT) + (size_t)l * DIN * DM, MTOT, DIN, DM}; pg8::StaticOrder S; S.init(MTOT, DIN, F.G, (int)blockIdx.x);
          pg8::EpiIn E{WSP(bf16, WS_U), WSP(bf16, WS_Q), WSP(bf16, WS_KT), WSP(bf16, WS_VT), A.out + O_KP + (size_t)l * MP * 256, A.out + O_VP + (size_t)l * MP * 256, A.out + O_KS + (size_t)l * DECB * 256, A.out + O_VS + (size_t)l * DECB * 256};
          pg8::gemm_phase<pg8::EpiIn, pg8::StaticOrder, true, true>(F.lds + RING_OFF, g, S, E); }
#endif
        xcd_barrier(bar);
#ifndef SK_MIX
        for (int u = F.vcu; u < 512; u += F.G) mixer_unit(F, l, u);
#endif
#ifndef SK_SMP
        for (int i = F.vcu; i < DECB; i += F.G) { sample_mixer_unit(F, l, i); sample_attn_unit(F, l, i); }
#endif
#ifndef SK_ATT
        attn_naive(F, l);
#endif
        xcd_barrier(bar);
#ifndef SK_P3
        { ARGS_BEGIN; ARG(I_XP); pg8::Gemm g{WSP(bf16, WS_MIX), WSP(bf16, WS_WOUTT) + (size_t)l * DM * DM, MP, DM, DM}; pg8::StaticOrder S; S.init(MP, DM, F.G, (int)blockIdx.x);
          pg8::EpiPre E{(l == 0) ? A.in[I_XP] : WSP(float, WS_XF), WSP(float, WS_PRE), ALPHA};
          pg8::gemm_phase<pg8::EpiPre, pg8::StaticOrder, true, true>(F.lds + RING_OFF, g, S, E); }
#endif
#ifndef SK_SOP
        sample_outproj(F, l);
#endif
        xcd_barrier(bar);
#ifndef SK_LN
        ln_rows(F, l);
#endif
        if (l + 1 < DEPTH) xcd_barrier(bar);
    }
}

extern "C" void kernel_launch(void* const* d_in, const int* in_sizes, int n_in, void* d_out, int out_size, void* d_ws, size_t ws_size, hipStream_t stream) {
    static int grid = 0;
    if (grid == 0) {
        if (n_in != 20 || out_size != (int)O_END || ws_size < WS_END) { fprintf(stderr, "kernel_launch: unexpected shapes: n_in %d out %d ws %zu\n", n_in, out_size, ws_size); grid = -1; return; }
        int dev = 0, cus = 0, per_cu = 0;
        if (hipGetDevice(&dev) != hipSuccess || hipDeviceGetAttribute(&cus, hipDeviceAttributeMultiprocessorCount, dev) != hipSuccess) { grid = -1; return; }
        if (hipFuncSetAttribute((const void*)fwd_kernel, hipFuncAttributeMaxDynamicSharedMemorySize, LDS_BYTES) != hipSuccess) { fprintf(stderr, "kernel_launch: hipFuncSetAttribute failed\n"); grid = -1; return; }
        if (hipOccupancyMaxActiveBlocksPerMultiprocessor(&per_cu, (const void*)fwd_kernel, NWAVES * 64, LDS_BYTES) != hipSuccess || per_cu < 1)
            fprintf(stderr, "kernel_launch: occupancy query reports %d workgroups per CU\n", per_cu);
        (void)hipGetLastError();
        grid = cus;
    }
    if (grid < 0) return;
    if (hipMemsetAsync((char*)d_ws + WS_CTL, 0, CTL_ZERO_BYTES, stream) != hipSuccess) return;
    Args a{};
    for (int i = 0; i < 20; ++i) a.in[i] = (const float*)d_in[i];
    a.out = (float*)d_out; a.ws = (unsigned char*)d_ws;
    hipLaunchKernelGGL(fwd_kernel, dim3(grid), dim3(NWAVES * 64), LDS_BYTES, stream, a);
}
```

```cpp
#include <hip/hip_runtime.h>
#include <cstdio>
#include <cstdint>
namespace pg8 {
#define PG8_LAS __attribute__((address_space(3)))
typedef unsigned short bf16_t;
typedef short bf16x8 __attribute__((ext_vector_type(8)));
typedef float f32x4 __attribute__((ext_vector_type(4)));
typedef unsigned u32x4 __attribute__((ext_vector_type(4)));
constexpr int BM = 256, BK = 64, HALF = 128, HTB = HALF * BK * 2  , STAGE_BYTES = 8 * HTB, NXCD = 8, WGM = 8;

__host__ __device__ __forceinline__ int lds_byte(int r, int c) { const int st = (r >> 4) * 2 + (c >> 5), rr = r & 15, cc = c & 31, ob = rr * 64 + cc * 2; return st * 1024 + (ob ^ (((ob >> 9) & 1) << 5)); }
__host__ __device__ __forceinline__ void stage_rc(int b, int& R, int& C) { const int st = b / 1024, sb = b % 1024, swz = sb ^ (((sb >> 9) & 1) << 5); R = (st >> 1) * 16 + swz / 64; C = (st & 1) * 32 + (swz % 64) / 2; }
__host__ __device__ __forceinline__ int perm32(int rho) { const int n = rho >> 4, i = rho & 15; return 8 * (i >> 2) + 4 * n + (i & 3); }

struct Unit { int pm, pn; };
struct Gemm { const bf16_t* A; const bf16_t* Bt; int M, N, K; };

struct StaticOrder {
    int nM, nN, nwg, G, c;
    __host__ __device__ void init(int M, int N, int G_, int c_) { nM = M / BM; nN = N / BM; nwg = nM * nN; G = G_; c = c_; }
    __host__ __device__ bool next(int i, Unit& u) const {
        const long L = (long)i * G + c; if (L >= nwg) return false;
        int wgid = (int)L; { const int q = nwg / NXCD, r = nwg % NXCD, xcd = wgid % NXCD, off = wgid / NXCD; wgid = (xcd < r ? xcd * (q + 1) : r * (q + 1) + (xcd - r) * q) + off; }
        const int nig = WGM * nN, gid = wgid / nig, fm = gid * WGM, gsz = (nM - fm) < WGM ? (nM - fm) : WGM;
        u.pm = fm + ((wgid % nig) % gsz); u.pn = (wgid % nig) / gsz; return true;
    }
    __device__ __forceinline__ void a_ready(const Unit&) const {}
    __device__ __forceinline__ void done(const Unit&) const {}
};

__device__ __forceinline__ unsigned cvt_pk_bf16(float lo, float hi) { unsigned r; asm volatile("v_cvt_pk_bf16_f32 %0, %1, %2" : "=v"(r) : "v"(lo), "v"(hi)); return r; }
typedef float f32x2 __attribute__((ext_vector_type(2)));
typedef unsigned u32x4 __attribute__((ext_vector_type(4)));
constexpr float QSCALE = 0.125f * 1.4426950408889634f;
struct EpiIn {
    static constexpr bool PERM = true, AFTER_DRAIN = false;
    bf16_t* U; bf16_t* Q; bf16_t* KT; bf16_t* VT; float* kout; float* vout; float* ksout; float* vsout;
    __device__ __forceinline__ void operator()(const f32x4 (&acc)[2][2][4][2], const Unit& u, int wr, int wc, int fr, int fq) const {
        const int pn = u.pn, pm = u.pm;
        int rowl = wr * 64 + fr, cl = wc * 32 + 8 * fq;
        asm volatile("" : "+v"(rowl), "+v"(cl));
        if (pm < 64 && pn >= 9 && pn <= 11) {
#pragma unroll
            for (int ai = 0; ai < 2; ++ai)
#pragma unroll
                for (int m = 0; m < 4; ++m) {
                    const int row = pm * 256 + ai * 128 + m * 16 + rowl, b = row >> 13, t = row & 8191;
#pragma unroll
                    for (int bj = 0; bj < 2; ++bj) {
                        const int c = bj * 128 + cl, head = c >> 6, d = c & 63, bh = b * 4 + head;
                        f32x4 v0 = acc[ai][bj][m][0], v1 = acc[ai][bj][m][1];
                        if (pn == 9) { v0 = v0 * QSCALE; v1 = v1 * QSCALE; }
                        u32x4 w; w.x = cvt_pk_bf16(v0[0], v0[1]); w.y = cvt_pk_bf16(v0[2], v0[3]); w.z = cvt_pk_bf16(v1[0], v1[1]); w.w = cvt_pk_bf16(v1[2], v1[3]);
                        if (pn == 9) { *(u32x4*)(Q + ((size_t)bh * 8192 + t) * 64 + d) = w; }
                        else if (pn == 10) {
                            float* o = kout + (size_t)row * 256 + c; *(f32x4*)o = v0; *(f32x4*)(o + 4) = v1;
                            *(u32x4*)(KT + (size_t)bh * 524288 + (size_t)(t >> 6) * 4096 + (d >> 3) * 512 + (t & 63) * 8) = w;
                        } else {
                            float* o = vout + (size_t)row * 256 + c; *(f32x4*)o = v0; *(f32x4*)(o + 4) = v1;
                            *(u32x4*)(VT + (size_t)bh * 524288 + (size_t)(t >> 6) * 4096 + (d >> 5) * 2048 + ((t >> 4) & 3) * 512 + (t & 15) * 32 + ((d >> 3) & 3) * 8) = w;
                        }
                    }
                }
        } else if (pm == 64 && (pn == 10 || pn == 11)) {
            float* ob = (pn == 10) ? ksout : vsout;
#pragma unroll
            for (int m = 0; m < 4; ++m) {
                const int i = m * 16 + rowl;
#pragma unroll
                for (int bj = 0; bj < 2; ++bj) { const int c = bj * 128 + cl; float* o = ob + (size_t)i * 256 + c; *(f32x4*)o = acc[0][bj][m][0]; *(f32x4*)(o + 4) = acc[0][bj][m][1]; }
            }
        } else {
            const float sc = (pn == 9) ? QSCALE : 1.0f;
#pragma unroll
            for (int ai = 0; ai < 2; ++ai)
#pragma unroll
                for (int m = 0; m < 4; ++m) {
                    const int row = pm * 256 + ai * 128 + m * 16 + rowl;
#pragma unroll
                    for (int bj = 0; bj < 2; ++bj) {
                        const int c = bj * 128 + cl;
                        const f32x4 v0 = acc[ai][bj][m][0] * sc, v1 = acc[ai][bj][m][1] * sc;
                        u32x4 w; w.x = cvt_pk_bf16(v0[0], v0[1]); w.y = cvt_pk_bf16(v0[2], v0[3]); w.z = cvt_pk_bf16(v1[0], v1[1]); w.w = cvt_pk_bf16(v1[2], v1[3]);
                        *(u32x4*)(U + (size_t)row * 3328 + pn * 256 + c) = w;
                    }
                }
        }
    }
};
struct EpiPre {
    static constexpr bool PERM = true, AFTER_DRAIN = false;
    const float* base; float* pre; float alpha;
    __device__ __forceinline__ void operator()(const f32x4 (&acc)[2][2][4][2], const Unit& u, int wr, int wc, int fr, int fq) const {
        int rowl = wr * 64 + fr, cl = wc * 32 + 8 * fq;
        asm volatile("" : "+v"(rowl), "+v"(cl));
#pragma unroll
        for (int ai = 0; ai < 2; ++ai)
#pragma unroll
            for (int m = 0; m < 4; ++m) {
                const int row = u.pm * 256 + ai * 128 + m * 16 + rowl;
#pragma unroll
                for (int bj = 0; bj < 2; ++bj) {
                    const size_t off = (size_t)row * 1024 + u.pn * 256 + bj * 128 + cl;
                    const f32x4 b0 = *(const f32x4*)(base + off), b1 = *(const f32x4*)(base + off + 4);
                    *(f32x4*)(pre + off) = b0 * alpha + acc[ai][bj][m][0]; *(f32x4*)(pre + off + 4) = b1 * alpha + acc[ai][bj][m][1];
                }
            }
    }
};
template <class Epi, class Sched, bool ALIGN_EPI = false, bool SP2 = false>
__device__ __forceinline__ void gemm_phase(PG8_LAS unsigned char* lds, const Gemm g, const Sched& S, const Epi& E) {
    int tid_ = threadIdx.x; asm volatile("" : "+v"(tid_));
    const int tid = tid_, wid = __builtin_amdgcn_readfirstlane(tid >> 6), lane = tid & 63, wr = wid >> 2, wc = wid & 3, fr = lane & 15, fq = lane >> 4;
    const int K = g.K, nt = K / BK;
    unsigned voffA[2], voffB[2];
#pragma unroll
    for (int i = 0; i < 2; ++i) { int R, C; stage_rc(tid * 16 + i * 8192, R, C); const int Rb = Epi::PERM ? ((R & ~31) + perm32(R & 31)) : R;
        voffA[i] = (unsigned)(R * K + C) * 2u; voffB[i] = (unsigned)(Rb * K + C) * 2u; }
    const size_t kstep = (size_t)(BK * 2);
    const size_t hstep = (size_t)HALF * K * 2;
    const size_t tstep = 2 * hstep;
    const unsigned ldsw = (unsigned)wid * 1024u;
    const int aoff = lds_byte(wr * 64 + fr, fq * 8), boff = lds_byte(wc * 32 + fr, fq * 8);
#define PG8_SA(b, h) (((b) * 2 + (h)) * HTB)
#define PG8_SB(b, h) ((4 + (b) * 2 + (h)) * HTB)
#define PG8_STAGE(bufoff, gbase, voff) do { _Pragma("unroll") for (int _i = 0; _i < 2; ++_i) \
        __builtin_amdgcn_global_load_lds((const unsigned*)((const char*)(gbase) + (voff)[_i]), (PG8_LAS unsigned*)(lds + (bufoff) + ldsw + _i * 8192), 16, 0, 0); } while (0)
#define PG8_LDA(dst, b, h) do { _Pragma("unroll") for (int m = 0; m < 4; ++m) _Pragma("unroll") for (int k = 0; k < 2; ++k) dst[m][k] = *(const PG8_LAS bf16x8*)(lds + PG8_SA(b, h) + aoff + m * 2048 + k * 1024); } while (0)
#define PG8_LDB(dst, b, h) do { _Pragma("unroll") for (int n = 0; n < 2; ++n) _Pragma("unroll") for (int k = 0; k < 2; ++k) dst[n][k] = *(const PG8_LAS bf16x8*)(lds + PG8_SB(b, h) + boff + n * 2048 + k * 1024); } while (0)
#define PG8_MMA(ai, bj, At, Bt) do { __builtin_amdgcn_s_setprio(1); _Pragma("unroll") for (int m = 0; m < 4; ++m) _Pragma("unroll") for (int n = 0; n < 2; ++n) _Pragma("unroll") for (int k = 0; k < 2; ++k) \
        acc[ai][bj][m][n] = __builtin_amdgcn_mfma_f32_16x16x32_bf16(Bt[n][k], At[m][k], acc[ai][bj][m][n], 0, 0, 0); __builtin_amdgcn_s_setprio(0); } while (0)
#define PG8_WAIT_V(n) asm volatile("s_waitcnt vmcnt(" #n ")" ::: "memory")
#define PG8_WAIT_L(n) asm volatile("s_waitcnt lgkmcnt(" #n ")" ::: "memory")
#define PG8_BAR __builtin_amdgcn_s_barrier()
#define PG8_SCHED __builtin_amdgcn_sched_barrier(0)
    Unit cur, nxt; int ui = 0;
    if (!S.next(0, cur)) return;
    f32x4 acc[2][2][4][2];
#pragma unroll
    for (int a = 0; a < 2; ++a)
#pragma unroll
        for (int b = 0; b < 2; ++b)
#pragma unroll
            for (int m = 0; m < 4; ++m)
#pragma unroll
                for (int n = 0; n < 2; ++n) acc[a][b][m][n] = (f32x4){0.f, 0.f, 0.f, 0.f};
    bf16x8 At[4][2], B0[2][2], B1[2][2];
    const char* cA = (const char*)g.A + (size_t)cur.pm * tstep; const char* cB = (const char*)g.Bt + (size_t)cur.pn * tstep;
    S.a_ready(cur);
    if constexpr (SP2) {
        PG8_STAGE(PG8_SB(0, 0), cB, voffB); PG8_STAGE(PG8_SB(0, 1), cB + hstep, voffB); PG8_STAGE(PG8_SA(0, 0), cA, voffA); PG8_STAGE(PG8_SA(0, 1), cA + hstep, voffA);
        if (wr == 1) PG8_BAR;
        PG8_WAIT_V(2); PG8_BAR;
        PG8_STAGE(PG8_SB(1, 0), cB + kstep, voffB); PG8_STAGE(PG8_SA(1, 0), cA + kstep, voffA); PG8_STAGE(PG8_SB(1, 1), cB + hstep + kstep, voffB);
        PG8_WAIT_V(6); PG8_BAR;
    } else {
        PG8_STAGE(PG8_SB(0, 0), cB, voffB); PG8_STAGE(PG8_SA(0, 0), cA, voffA); PG8_STAGE(PG8_SB(0, 1), cB + hstep, voffB); PG8_STAGE(PG8_SA(0, 1), cA + hstep, voffA);
        if (wr == 1) PG8_BAR;
        PG8_WAIT_V(4); PG8_BAR;
        PG8_STAGE(PG8_SB(1, 0), cB + kstep, voffB); PG8_STAGE(PG8_SA(1, 0), cA + kstep, voffA); PG8_STAGE(PG8_SB(1, 1), cB + hstep + kstep, voffB);
        PG8_WAIT_V(6); PG8_BAR;
    }
    for (;;) {
        const bool has_next = S.next(ui + 1, nxt);
        const char* nA = has_next ? (const char*)g.A + (size_t)nxt.pm * tstep : cA; const char* nB = has_next ? (const char*)g.Bt + (size_t)nxt.pn * tstep : cB;
        for (int t = 0; t < nt; t += 2) {
            const bool last = (t == nt - 2);
            const char* a1 = cA + (size_t)(t + 1) * kstep;
            const char* a2 = last ? nA : cA + (size_t)(t + 2) * kstep; const char* b2 = last ? nB : cB + (size_t)(t + 2) * kstep;
            const char* a3 = a2 + kstep; const char* b3 = b2 + kstep;
            if (last && has_next) S.a_ready(nxt);
            if constexpr (SP2) {
            PG8_LDB(B0, 0, 0); PG8_LDB(B1, 0, 1); PG8_SCHED; PG8_LDA(At, 0, 0); PG8_STAGE(PG8_SA(1, 1), a1 + hstep, voffA);
            PG8_WAIT_V(8); PG8_WAIT_L(0); PG8_BAR; PG8_MMA(0, 0, At, B0); PG8_MMA(0, 1, At, B1); PG8_BAR; PG8_SCHED;
            PG8_LDA(At, 0, 1); PG8_STAGE(PG8_SB(0, 0), b2, voffB); PG8_STAGE(PG8_SB(0, 1), b2 + hstep, voffB); PG8_STAGE(PG8_SA(0, 0), a2, voffA);
            PG8_WAIT_V(8); PG8_WAIT_L(0); PG8_BAR; PG8_MMA(1, 0, At, B0); PG8_MMA(1, 1, At, B1); PG8_BAR; PG8_SCHED;
            PG8_LDB(B0, 1, 0); PG8_LDB(B1, 1, 1); PG8_SCHED; PG8_LDA(At, 1, 0); PG8_STAGE(PG8_SA(0, 1), a2 + hstep, voffA);
            PG8_WAIT_V(8); PG8_WAIT_L(0); PG8_BAR; PG8_MMA(0, 0, At, B0); PG8_MMA(0, 1, At, B1); PG8_BAR; PG8_SCHED;
            PG8_LDA(At, 1, 1); PG8_STAGE(PG8_SB(1, 0), b3, voffB); PG8_STAGE(PG8_SB(1, 1), b3 + hstep, voffB); PG8_STAGE(PG8_SA(1, 0), a3, voffA);
            PG8_WAIT_V(8); PG8_WAIT_L(0); PG8_BAR; PG8_MMA(1, 0, At, B0); PG8_MMA(1, 1, At, B1); PG8_BAR; PG8_SCHED;
            } else {
            PG8_LDB(B0, 0, 0); PG8_SCHED; PG8_LDA(At, 0, 0); PG8_STAGE(PG8_SA(1, 1), a1 + hstep, voffA);
            PG8_WAIT_L(8); PG8_BAR; PG8_WAIT_L(0); PG8_MMA(0, 0, At, B0); PG8_BAR; PG8_SCHED;
            PG8_LDB(B1, 0, 1); PG8_STAGE(PG8_SB(0, 0), b2, voffB);
            PG8_BAR; PG8_WAIT_L(0); PG8_MMA(0, 1, At, B1); PG8_BAR;
            PG8_LDA(At, 0, 1); PG8_STAGE(PG8_SA(0, 0), a2, voffA);
            PG8_BAR; PG8_WAIT_L(0); PG8_MMA(1, 0, At, B0); PG8_BAR; PG8_SCHED;
            PG8_STAGE(PG8_SB(0, 1), b2 + hstep, voffB);
            PG8_WAIT_V(6); PG8_BAR; PG8_MMA(1, 1, At, B1); PG8_BAR;
            PG8_LDB(B0, 1, 0); PG8_SCHED; PG8_LDA(At, 1, 0); PG8_STAGE(PG8_SA(0, 1), a2 + hstep, voffA);
            PG8_WAIT_L(8); PG8_BAR; PG8_WAIT_L(0); PG8_MMA(0, 0, At, B0); PG8_BAR; PG8_SCHED;
            PG8_LDB(B1, 1, 1); PG8_STAGE(PG8_SB(1, 0), b3, voffB);
            PG8_BAR; PG8_WAIT_L(0); PG8_MMA(0, 1, At, B1); PG8_BAR;
            PG8_LDA(At, 1, 1); PG8_STAGE(PG8_SA(1, 0), a3, voffA);
            PG8_BAR; PG8_WAIT_L(0); PG8_MMA(1, 0, At, B0); PG8_BAR; PG8_SCHED;
            PG8_STAGE(PG8_SB(1, 1), b3 + hstep, voffB);
            PG8_WAIT_V(6); PG8_BAR; PG8_MMA(1, 1, At, B1); PG8_BAR;
            }
        }
        if constexpr (ALIGN_EPI) { if (wr == 0) PG8_BAR; }
        if constexpr (!Epi::AFTER_DRAIN) { E(acc, cur, wr, wc, fr, fq); S.done(cur); }
        if (!has_next) break;
#pragma unroll
        for (int a = 0; a < 2; ++a)
#pragma unroll
            for (int b = 0; b < 2; ++b)
#pragma unroll
                for (int m = 0; m < 4; ++m)
#pragma unroll
                    for (int n = 0; n < 2; ++n) acc[a][b][m][n] = (f32x4){0.f, 0.f, 0.f, 0.f};
        cur = nxt; cA = nA; cB = nB; ++ui;
        if constexpr (ALIGN_EPI) { if (wr == 1) PG8_BAR; }
    }
    PG8_WAIT_V(0);
    if constexpr (!ALIGN_EPI) { if (wr == 0) PG8_BAR; }
    PG8_BAR;
    if constexpr (Epi::AFTER_DRAIN) { E.fused(acc, cur, wr, wc, fr, fq, lds, wid, lane); S.done(cur); }
#undef PG8_SA
#undef PG8_SB
#undef PG8_STAGE
#undef PG8_LDA
#undef PG8_LDB
#undef PG8_MMA
#undef PG8_WAIT_V
#undef PG8_WAIT_L
#undef PG8_BAR
#undef PG8_SCHED
}
}
constexpr int DM = 1024, NB = 2, SEQ = 8192, DEPTH = 2, DECB = 128, PAST = 2048, PAGE = 128, NPG = 16, NPOOLPG = 2560;
constexpr int MP = NB * SEQ;
constexpr int MTOT = MP + 256;
constexpr int MLN = MP + DECB;
constexpr int DIN = 3328;
constexpr float LN_EPS = 1e-5f, ALPHA = 1.4142135623730951f, LOG2E = 1.4426950408889634f;
constexpr size_t O_YP = 0, O_YS = O_YP + (size_t)MP * DM, O_CAP = O_YS + (size_t)DECB * DM, O_CAS = O_CAP + (size_t)DEPTH * NB * 2 * 256,
                 O_CBP = O_CAS + (size_t)DEPTH * DECB * 2 * 256, O_CBS = O_CBP + (size_t)DEPTH * NB * 30 * 256, O_PLP = O_CBS + (size_t)DEPTH * DECB * 30 * 256,
                 O_PLS = O_PLP + (size_t)DEPTH * NB * 15 * 256, O_KP = O_PLS + (size_t)DEPTH * DECB * 15 * 256, O_VP = O_KP + (size_t)DEPTH * MP * 256,
                 O_KS = O_VP + (size_t)DEPTH * MP * 256, O_VS = O_KS + (size_t)DEPTH * DECB * 256, O_END = O_VS + (size_t)DEPTH * DECB * 256;
static_assert(O_END == 36944896, "output size");
constexpr size_t MiB = 1u << 20;
constexpr size_t WS_CTL = 0, CTL_ZERO_BYTES = 1 * MiB;
constexpr size_t WS_WINT = 2 * MiB;
constexpr size_t WS_WOUTT = 16 * MiB;
constexpr size_t WS_XB = 32 * MiB;
constexpr size_t WS_MIX = 66 * MiB;
constexpr size_t WS_Q = 100 * MiB, WS_KT = 108 * MiB, WS_VT = 116 * MiB;
constexpr size_t WS_U = 128 * MiB;
constexpr size_t WS_PRE = 236 * MiB;
constexpr size_t WS_XF = 304 * MiB;
constexpr size_t WS_END = 370 * MiB;
static_assert(WS_WINT + (size_t)DEPTH * DIN * DM * 2 <= WS_WOUTT && WS_WOUTT + (size_t)DEPTH * DM * DM * 2 <= WS_XB && WS_XB + (size_t)MTOT * DM * 2 <= WS_MIX &&
              WS_MIX + (size_t)MTOT * DM * 2 <= WS_Q && WS_U + (size_t)MTOT * DIN * 2 <= WS_PRE && WS_PRE + (size_t)MLN * DM * 4 <= WS_XF && WS_XF + (size_t)MLN * DM * 4 <= WS_END, "d_ws map");
constexpr int CW_BAR = 4096;
constexpr int NWAVES = 8;
constexpr int RING_OFF = 0, RING_BYTES = 131072;
constexpr int LDSCTL_OFF = RING_BYTES, MISC_OFF = LDSCTL_OFF + 320;
constexpr int LDS_BYTES = 147456;
#define GAS __attribute__((address_space(1)))
#define LAS __attribute__((address_space(3)))
typedef unsigned short bf16;
typedef unsigned v4u __attribute__((ext_vector_type(4)));
typedef float f32x4 __attribute__((ext_vector_type(4)));
typedef short bf16x8 __attribute__((ext_vector_type(8)));
typedef unsigned u32x4 __attribute__((ext_vector_type(4)));
typedef GAS unsigned gu32;
typedef GAS unsigned long long gu64;
#define RLX_AGENT __ATOMIC_RELAXED, __HIP_MEMORY_SCOPE_AGENT
#define LDS_WAIT() asm volatile("s_waitcnt lgkmcnt(0)" ::: "memory")
#define VM_WAIT() asm volatile("s_waitcnt vmcnt(0)" ::: "memory")
__device__ __forceinline__ unsigned long long rt() { return __builtin_amdgcn_s_memrealtime(); }
__device__ __forceinline__ unsigned f2bf(float f) { unsigned u = __builtin_bit_cast(unsigned, f); return (u + 0x7fffu + ((u >> 16) & 1u)) >> 16; }
__device__ __forceinline__ unsigned pk2(float lo, float hi) { return f2bf(lo) | (f2bf(hi) << 16); }
#define XB_TMO      128
#define XB_XCNT(j)  (256  + 64 * (j))
#define XB_XSUB(j)  (1280 + 64 * (j))
#define XB_XGEN(j)  (2304 + 64 * (j))
#define XB_TOP      3328
#define XB_TOPGEN   3392
#define XCD_BAR_WORDS 3456
#define XB_SPIN_CAP (1u << 18)

__device__ __forceinline__ unsigned xb_ld(unsigned* p)              { return __hip_atomic_load(p, __ATOMIC_RELAXED, __HIP_MEMORY_SCOPE_AGENT); }
__device__ __forceinline__ unsigned xb_add(unsigned* p, unsigned v) { return __hip_atomic_fetch_add(p, v, __ATOMIC_RELAXED, __HIP_MEMORY_SCOPE_AGENT); }
__device__ __forceinline__ unsigned xb_xcc_id() { return (unsigned)__builtin_amdgcn_s_getreg((3 << 11) | 20) & 0xFu; }
#define XB_SPIN(cond, bar) do { unsigned _sp = 0; while (cond) { __builtin_amdgcn_s_sleep(1); \
    if ((++_sp & 255u) == 0u) { if (xb_ld(&(bar)[XB_TMO])) break; if (_sp > XB_SPIN_CAP) { atomicAdd(&(bar)[XB_TMO], 1u); break; } } } } while (0)

struct XcdBarrier {
    unsigned* bar; unsigned x;
    volatile LAS unsigned* st;
};

__device__ __forceinline__ XcdBarrier xcd_barrier_post(unsigned* bar, volatile LAS unsigned* st) {
    XcdBarrier b; b.bar = bar; b.x = xb_xcc_id(); b.st = st;
    if (threadIdx.x == 0) (void)xb_add(&bar[XB_XCNT(b.x)], 1u);
    return b;
}
__device__ __forceinline__ void xcd_barrier_complete(unsigned* bar, unsigned x, unsigned& nloc, unsigned& nx) {
    const unsigned G = gridDim.x * gridDim.y * gridDim.z;
    unsigned sum, cnt, mine, sp = 0u;
    for (;;) {
        sum = 0u; cnt = 0u; mine = 0u;
#pragma unroll
        for (unsigned j = 0; j < 16; ++j) { const unsigned c = xb_ld(&bar[XB_XCNT(j)]); sum += c; cnt += (c > 0u) ? 1u : 0u; mine = (j == x) ? c : mine; }
        if (sum == G) break;
        __builtin_amdgcn_s_sleep(1);
        if ((++sp & 255u) == 0u) { if (xb_ld(&bar[XB_TMO])) break; if (sp > XB_SPIN_CAP) { atomicAdd(&bar[XB_TMO], 1u); break; } }
    }
    nloc = mine > 0u ? mine : 1u; nx = cnt > 0u ? cnt : 1u;
}

__device__ __forceinline__ void xcd_barrier(const XcdBarrier& b) {
    asm volatile("s_waitcnt vmcnt(0)" ::: "memory");
    __syncthreads();
    if (threadIdx.x == 0) {
        unsigned* bar = b.bar;
        __builtin_amdgcn_s_waitcnt(0);
        unsigned nloc = b.st[0], nx = b.st[1];
        if (nloc == 0u) { xcd_barrier_complete(bar, b.x, nloc, nx); b.st[0] = nloc; b.st[1] = nx; }
        const unsigned old = xb_add(&bar[XB_XSUB(b.x)], 1u);
        const unsigned gen = old / nloc;
        if (old + 1u == (gen + 1u) * nloc) {
            __builtin_amdgcn_fence(__ATOMIC_RELEASE, "agent");
            asm volatile("s_waitcnt vmcnt(0)" ::: "memory");
            const unsigned og = xb_add(&bar[XB_TOP], 1u);
            const unsigned tg = og / nx;
            if (og + 1u == (tg + 1u) * nx) xb_add(&bar[XB_TOPGEN], 1u);
            else XB_SPIN(xb_ld(&bar[XB_TOPGEN]) == tg, bar);
            __builtin_amdgcn_fence(__ATOMIC_ACQUIRE, "agent");
            xb_add(&bar[XB_XGEN(b.x)], 1u);
            asm volatile("s_waitcnt vmcnt(0)" ::: "memory");
        } else {
            XB_SPIN(xb_ld(&bar[XB_XGEN(b.x)]) == gen, bar);
            __builtin_amdgcn_fence(__ATOMIC_ACQUIRE, "agent");
            asm volatile("s_waitcnt vmcnt(0)" ::: "memory");
        }
    }
    __syncthreads();
}
__device__ __forceinline__ float wave_sum(float v) {
#pragma unroll
    for (int o = 1; o < 64; o <<= 1) v += __shfl_xor(v, o);
    return v;
}
__device__ __forceinline__ void p0_transpose_item(const float* W, int K, int N, bf16* WT, int row_off, LAS float* scr, int item, int lane) {
    const int nblk = N / 32, kb = item / nblk, nb = item % nblk, k0 = 64 * kb, n0 = 32 * nb;
#pragma unroll 8
    for (int i = 0; i < 32; ++i) { const int kk = 2 * i + (lane >> 5); scr[kk * 33 + (lane & 31)] = W[(size_t)(k0 + kk) * N + n0 + (lane & 31)]; }
    LDS_WAIT(); asm volatile("" ::: "memory");
    const int c = lane & 7;
#pragma unroll
    for (int j = 0; j < 4; ++j) { const int n = (lane >> 3) + 8 * j; const LAS float* s = scr + (8 * c) * 33 + n;
        v4u o; o.x = pk2(s[0 * 33], s[1 * 33]); o.y = pk2(s[2 * 33], s[3 * 33]); o.z = pk2(s[4 * 33], s[5 * 33]); o.w = pk2(s[6 * 33], s[7 * 33]);
        *(GAS v4u*)(WT + (size_t)(row_off + n0 + n) * K + k0 + 8 * c) = o; }
    LDS_WAIT(); asm volatile("" ::: "memory");
}
__device__ __forceinline__ int lane_id() { return (int)__builtin_amdgcn_mbcnt_hi(~0u, __builtin_amdgcn_mbcnt_lo(~0u, 0u)); }
__device__ __forceinline__ float bf2f(unsigned short v) { return __uint_as_float((unsigned)v << 16); }
__device__ __forceinline__ float bflo(unsigned v) { return __uint_as_float(v << 16); }
__device__ __forceinline__ float bfhi(unsigned v) { return __uint_as_float(v & 0xffff0000u); }
__device__ __forceinline__ float ex2(float x) { return __builtin_amdgcn_exp2f(x); }
__device__ __forceinline__ float lg2(float x) { return __builtin_amdgcn_logf(x); }
__device__ __forceinline__ float sigmoidf_(float x) { return 1.0f / (1.0f + ex2(-x * LOG2E)); }
__device__ __forceinline__ float siluf_(float x) { return x * sigmoidf_(x); }

struct Args { const float* in[20]; float* out; unsigned char* ws; };
#define WSP(T, off) ((T*)(A.ws + (off)))
typedef __attribute__((address_space(4))) const Args CArgs;
#define KARGS ((CArgs*)__builtin_amdgcn_kernarg_segment_ptr())
#define KIN(k) (*(const float* const volatile __attribute__((address_space(4)))*)&KARGS->in[k])
#define KOUT (*(float* const volatile __attribute__((address_space(4)))*)&KARGS->out)
#define KWS (*(unsigned char* const volatile __attribute__((address_space(4)))*)&KARGS->ws)
#define ARGS_BEGIN Args A; A.ws = KWS; A.out = KOUT
#define ARG(k) A.in[k] = KIN(k)
struct Frame {
    LAS unsigned char* lds;
    volatile LAS unsigned* MISC;
    gu32* ctl;
    int tid, lane, wave, vcu, G;
};
enum { I_XP = 0, I_XS, I_CK, I_CV, I_PT, I_SCA, I_SCB, I_SPL, I_WIN, I_CAW, I_CBW, I_CBB, I_NBG, I_NBB, I_PW, I_PS, I_WOUT, I_LNG, I_LNB, I_SBB };

__device__ __forceinline__ void row_to_bf16(const float* xrow, bf16* orow, int lane) {
    const GAS f32x4* xr = (const GAS f32x4*)xrow + lane;
    GAS unsigned long long* o8 = (GAS unsigned long long*)orow + lane;
#pragma unroll
    for (int j = 0; j < 4; ++j) { const f32x4 v = xr[64 * j]; o8[64 * j] = (unsigned long long)pk2(v.x, v.y) | ((unsigned long long)pk2(v.z, v.w) << 32); }
}
__device__ __forceinline__ void prologue(Frame& F) {
    int tid_l = F.tid; asm volatile("" : "+v"(tid_l)); const int lane_l = tid_l & 63;
    ARGS_BEGIN; ARG(I_WIN); ARG(I_WOUT); ARG(I_XP); ARG(I_XS);
    LAS float* scr = (LAS float*)(F.lds + RING_OFF + F.wave * 16384);
    const int gw = F.vcu * NWAVES + F.wave, NGW = F.G * NWAVES;
    constexpr int I_IN = (DM / 64) * (DIN / 32), I_OUT = (DM / 64) * (DM / 32);
    constexpr int NITEMS = DEPTH * (I_IN + I_OUT);
    for (int it = gw; it < NITEMS; it += NGW) {
        int r = it; const int l = r / (I_IN + I_OUT); r -= l * (I_IN + I_OUT);
        if (r < I_IN) p0_transpose_item(A.in[I_WIN] + (size_t)l * DM * DIN, DM, DIN, WSP(bf16, WS_WINT) + (size_t)l * DIN * DM, 0, scr, r, lane_l);
        else p0_transpose_item(A.in[I_WOUT] + (size_t)l * DM * DM, DM, DM, WSP(bf16, WS_WOUTT) + (size_t)l * DM * DM, 0, scr, r - I_IN, lane_l);
    }
    for (int m = gw; m < MTOT; m += NGW) {
        if (m < MP) row_to_bf16(A.in[I_XP] + (size_t)m * DM, WSP(bf16, WS_XB) + (size_t)m * DM, lane_l);
        else if (m < MP + DECB) row_to_bf16(A.in[I_XS] + (size_t)(m - MP) * DM, WSP(bf16, WS_XB) + (size_t)m * DM, lane_l);
        else { GAS unsigned long long* o8 = (GAS unsigned long long*)(WSP(bf16, WS_XB) + (size_t)m * DM) + lane_l;
#pragma unroll
            for (int j = 0; j < 4; ++j) o8[64 * j] = 0ull; }
    }
}

__device__ __forceinline__ void mixer_unit(Frame& F, int l, int unit) {
    int tid_l = F.tid; asm volatile("" : "+v"(tid_l)); const int lane_l = tid_l & 63;
    ARGS_BEGIN; ARG(I_CBW); ARG(I_CBB); ARG(I_NBG); ARG(I_NBB); ARG(I_CAW); ARG(I_PW); ARG(I_PS);
    const int b = unit >> 8, t0 = (unit & 255) * 32, c = tid_l & 255, half = tid_l >> 8;
    LAS float* G = (LAS float*)(F.lds);
    LAS float* BC = (LAS float*)(F.lds + 63488);
    LAS float* DIFF = (LAS float*)(F.lds + 96256);
    LAS float* CV = G;
    const bf16* Ub = WSP(bf16, WS_U) + (size_t)b * SEQ * DIN;
    float* out = A.out;
#pragma unroll 1
    for (int gr = half; gr < 62; gr += 2) { const int t = t0 - 30 + gr; float v = 0.f;
        if (t >= 0) { const bf16* ur = Ub + (size_t)t * DIN; v = bf2f(ur[1024 + c]) * sigmoidf_(bf2f(ur[1280 + c])); }
        G[gr * 256 + c] = v; }
    __syncthreads();
    if (t0 == SEQ - 32) for (int k = half; k < 30; k += 2) out[O_CBP + ((size_t)(l * NB + b) * 30 + k) * 256 + c] = G[(k + 32) * 256 + c];
    { const float* wbp = A.in[I_CBW] + (size_t)l * 31 * 256 + c;
      const float bias = A.in[I_CBB][l * 256 + c];
#pragma unroll 1
      for (int r = 0; r < 16; ++r) { const int tt = half * 16 + r; float s = bias;
#pragma unroll 4
          for (int k = 0; k < 31; ++k) s += wbp[k * 256] * G[(tt + k) * 256 + c];
          BC[tt * 256 + c] = s; } }
    __syncthreads();
#pragma unroll 1
    for (int rr = 0; rr < 4; ++rr) { const int tt = F.wave * 4 + rr; float x[4]; float s = 0.f;
#pragma unroll
        for (int j = 0; j < 4; ++j) { x[j] = BC[tt * 256 + lane_l + 64 * j]; s += x[j]; }
        const float mean = wave_sum(s) * (1.f / 256.f); float q = 0.f;
#pragma unroll
        for (int j = 0; j < 4; ++j) { x[j] -= mean; q += x[j] * x[j]; }
        const float rstd = 1.0f / sqrtf(wave_sum(q) * (1.f / 256.f) + LN_EPS);
        const bf16* ur = Ub + (size_t)(t0 + tt) * DIN; bf16* mr = WSP(bf16, WS_MIX) + ((size_t)b * SEQ + t0 + tt) * DM;
#pragma unroll
        for (int j = 0; j < 4; ++j) { const int cc = lane_l + 64 * j; const float y = x[j] * rstd * A.in[I_NBG][l * 256 + cc] + A.in[I_NBB][l * 256 + cc];
            mr[256 + cc] = (bf16)f2bf(siluf_(y) * siluf_(bf2f(ur[1536 + cc]))); } }
    { const float w0 = A.in[I_CAW][(l * 3 + 0) * 256 + c], w1 = A.in[I_CAW][(l * 3 + 1) * 256 + c], w2 = A.in[I_CAW][(l * 3 + 2) * 256 + c];
      const int ts = t0 + half * 16; float p2 = 0.f, p1 = 0.f;
      if (ts - 2 >= 0) { const bf16* ur = Ub + (size_t)(ts - 2) * DIN; p2 = bf2f(ur[512 + c]) * bf2f(ur[c]); }
      if (ts - 1 >= 0) { const bf16* ur = Ub + (size_t)(ts - 1) * DIN; p1 = bf2f(ur[512 + c]) * bf2f(ur[c]); }
#pragma unroll 1
      for (int r = 0; r < 16; ++r) { const int t = ts + r; const bf16* ur = Ub + (size_t)t * DIN;
          const float cur = bf2f(ur[512 + c]) * bf2f(ur[c]); const float cv = w0 * p2 + w1 * p1 + w2 * cur;
          WSP(bf16, WS_MIX)[((size_t)b * SEQ + t) * DM + c] = (bf16)f2bf(bf2f(ur[256 + c]) * cv * siluf_(bf2f(ur[768 + c])));
          p2 = p1; p1 = cur; }
      if (t0 == SEQ - 32 && half == 1) { out[O_CAP + ((size_t)(l * NB + b) * 2 + 0) * 256 + c] = p2; out[O_CAP + ((size_t)(l * NB + b) * 2 + 1) * 256 + c] = p1; } }
    __syncthreads();
#pragma unroll 1
    for (int cr = half; cr < 47; cr += 2) { const int t = t0 - 15 + cr; float v = 0.f; if (t >= 0) v = bf2f(Ub[(size_t)t * DIN + 1792 + c]); CV[cr * 256 + c] = v; }
    __syncthreads();
    if (t0 == SEQ - 32) for (int k = half; k < 15; k += 2) out[O_PLP + ((size_t)(l * NB + b) * 15 + k) * 256 + c] = CV[(k + 32) * 256 + c];
    { const int g = c >> 6, w = 2 << g;
#pragma unroll 1
      for (int r = 0; r < 16; ++r) { const int tt = half * 16 + r, t = t0 + tt; float win = 0.f;
#pragma unroll 1
          for (int k = 0; k < w; ++k) win += CV[(tt + 15 - k) * 256 + c];
          const int cnt = (t + 1 < w) ? t + 1 : w;
          DIFF[tt * 256 + c] = win / (float)cnt - CV[(tt + 15) * 256 + c]; } }
    __syncthreads();
    { const int g = c >> 6, d = c & 63; const float* pwp = A.in[I_PW] + ((size_t)(l * 4 + g) * 64) * 64 + d;
      const float ps = A.in[I_PS][l * 256 + c];
#pragma unroll 1
      for (int r = 0; r < 16; ++r) { const int tt = half * 16 + r, t = t0 + tt; float y = 0.f;
#pragma unroll 4
          for (int cc = 0; cc < 64; ++cc) y += DIFF[tt * 256 + g * 64 + cc] * pwp[cc * 64];
          WSP(bf16, WS_MIX)[((size_t)b * SEQ + t) * DM + 512 + c] = (bf16)f2bf(y * ps * siluf_(bf2f(Ub[(size_t)t * DIN + 2048 + c]))); } }
    __syncthreads();
}

__device__ __forceinline__ void sample_mixer_unit(Frame& F, int l, int i) {
    int tid_l = F.tid; asm volatile("" : "+v"(tid_l)); const int lane_l = tid_l & 63;
    ARGS_BEGIN; ARG(I_SCA); ARG(I_SCB); ARG(I_SPL); ARG(I_CBW); ARG(I_CBB); ARG(I_NBG); ARG(I_NBB); ARG(I_CAW); ARG(I_PW); ARG(I_PS);
    LAS float* red = (LAS float*)(F.lds);
    LAS float* DIFF = (LAS float*)(F.lds + 1024);
    const int c = tid_l & 255; const bool act = tid_l < 256;
    const bf16* ur = WSP(bf16, WS_U) + (size_t)(MP + i) * DIN; bf16* mr = WSP(bf16, WS_MIX) + (size_t)(MP + i) * DM; float* out = A.out;
    float bc = 0.f;
    if (act) {
        const float* ha = A.in[I_SCA] + ((size_t)(l * DECB + i) * 2) * 256;
        const float ah = bf2f(ur[512 + c]) * bf2f(ur[c]);
        const float cv = A.in[I_CAW][(l * 3 + 0) * 256 + c] * ha[c] + A.in[I_CAW][(l * 3 + 1) * 256 + c] * ha[256 + c] + A.in[I_CAW][(l * 3 + 2) * 256 + c] * ah;
        mr[c] = (bf16)f2bf(bf2f(ur[256 + c]) * cv * siluf_(bf2f(ur[768 + c])));
        out[O_CAS + ((size_t)(l * DECB + i) * 2 + 0) * 256 + c] = ha[256 + c]; out[O_CAS + ((size_t)(l * DECB + i) * 2 + 1) * 256 + c] = ah;
        const float* hb = A.in[I_SCB] + ((size_t)(l * DECB + i) * 30) * 256;
        const float glu = bf2f(ur[1024 + c]) * sigmoidf_(bf2f(ur[1280 + c]));
        bc = A.in[I_CBB][l * 256 + c] + A.in[I_CBW][(l * 31 + 30) * 256 + c] * glu;
        float* ob = out + O_CBS + ((size_t)(l * DECB + i) * 30) * 256;
#pragma unroll 2
        for (int k = 0; k < 30; ++k) { const float h = hb[k * 256 + c]; bc += A.in[I_CBW][(l * 31 + k) * 256 + c] * h; if (k >= 1) ob[(k - 1) * 256 + c] = h; }
        ob[29 * 256 + c] = glu;
    }
    float s = act ? bc : 0.f; s = wave_sum(s); if (lane_l == 0) red[F.wave] = s;
    __syncthreads();
    const float mean = (red[0] + red[1] + red[2] + red[3]) * (1.f / 256.f);
    const float dv = bc - mean; float q = act ? dv * dv : 0.f; q = wave_sum(q); if (lane_l == 0) red[8 + F.wave] = q;
    __syncthreads();
    const float rstd = 1.0f / sqrtf((red[8] + red[9] + red[10] + red[11]) * (1.f / 256.f) + LN_EPS);
    if (act) {
        const float y = dv * rstd * A.in[I_NBG][l * 256 + c] + A.in[I_NBB][l * 256 + c];
        mr[256 + c] = (bf16)f2bf(siluf_(y) * siluf_(bf2f(ur[1536 + c])));
        const float* hc = A.in[I_SPL] + ((size_t)(l * DECB + i) * 15) * 256;
        const float cvv = bf2f(ur[1792 + c]); const int g = c >> 6, w = 2 << g; float win = cvv;
        float* op = out + O_PLS + ((size_t)(l * DECB + i) * 15) * 256;
#pragma unroll 1
        for (int k = 0; k < 15; ++k) { const float h = hc[k * 256 + c]; if (k >= 15 - (w - 1)) win += h; if (k >= 1) op[(k - 1) * 256 + c] = h; }
        op[14 * 256 + c] = cvv;
        DIFF[c] = win / (float)w - cvv;
    }
    __syncthreads();
    if (act) { const int g = c >> 6, d = c & 63; float y = 0.f;
#pragma unroll 4
        for (int cc = 0; cc < 64; ++cc) y += DIFF[g * 64 + cc] * A.in[I_PW][((size_t)(l * 4 + g) * 64 + cc) * 64 + d];
        mr[512 + c] = (bf16)f2bf(y * A.in[I_PS][l * 256 + c] * siluf_(bf2f(ur[2048 + c]))); }
    __syncthreads();
}

__device__ __forceinline__ void attn_naive(Frame& F, int l) {
    int tid_l = F.tid; asm volatile("" : "+v"(tid_l)); const int lane_l = tid_l & 63;
    ARGS_BEGIN; ARG(I_SBB);
    const int gw = F.vcu * NWAVES + F.wave, NGW = F.G * NWAVES, lane = lane_l;
    for (int idx = gw; idx < 4 * MP; idx += NGW) {
        const int bh = idx >> 13, t = idx & 8191, b = bh >> 2, h = bh & 3;
        const float bias2 = A.in[I_SBB][l * 4 + h] * LOG2E;
        float qf[64];
        { const u32x4* qp = (const u32x4*)(WSP(bf16, WS_Q) + ((size_t)bh * SEQ + t) * 64);
#pragma unroll
          for (int cch = 0; cch < 8; ++cch) { const u32x4 v = qp[cch];
              qf[8 * cch + 0] = bflo(v.x); qf[8 * cch + 1] = bfhi(v.x); qf[8 * cch + 2] = bflo(v.y); qf[8 * cch + 3] = bfhi(v.y);
              qf[8 * cch + 4] = bflo(v.z); qf[8 * cch + 5] = bfhi(v.z); qf[8 * cch + 6] = bflo(v.w); qf[8 * cch + 7] = bfhi(v.w); } }
        const bf16* Kb = WSP(bf16, WS_KT) + (size_t)bh * 524288; const bf16* Vb = WSP(bf16, WS_VT) + (size_t)bh * 524288;
        float L = 0.f, o = 0.f;
        for (int j = (t - 1) >> 6; j >= 0 && t > 0; --j) {
            const int s = 64 * j + lane; float z = 0.f;
#pragma unroll
            for (int cch = 0; cch < 8; ++cch) { const u32x4 v = *(const u32x4*)(Kb + (size_t)j * 4096 + cch * 512 + lane * 8);
                z += qf[8 * cch + 0] * bflo(v.x) + qf[8 * cch + 1] * bfhi(v.x) + qf[8 * cch + 2] * bflo(v.y) + qf[8 * cch + 3] * bfhi(v.y)
                   + qf[8 * cch + 4] * bflo(v.z) + qf[8 * cch + 5] * bfhi(v.z) + qf[8 * cch + 6] * bflo(v.w) + qf[8 * cch + 7] * bfhi(v.w); }
            const bool valid = s < t; const float z2 = fminf(z + bias2, 100.f);
            const float lk = valid ? -lg2(1.0f + ex2(z2)) : 0.f;
            float sfx = lk;
#pragma unroll
            for (int dl = 1; dl < 64; dl <<= 1) { const float y = __shfl_down(sfx, dl); if (lane + dl < 64) sfx += y; }
            const float a = valid ? ex2(z2 + sfx + L) : 0.f;
            L += __shfl(sfx, 0);
            const bf16* vt = Vb + (size_t)j * 4096 + (lane >> 5) * 2048 + ((lane >> 3) & 3) * 8 + (lane & 7);
#pragma unroll
            for (int s2 = 0; s2 < 64; ++s2) { const float as = __uint_as_float(__builtin_amdgcn_readlane(__float_as_uint(a), s2)); o += as * bf2f(vt[(s2 >> 4) * 512 + (s2 & 15) * 32]); }
        }
        const size_t row = (size_t)b * SEQ + t;
        WSP(bf16, WS_MIX)[row * DM + 768 + h * 64 + lane] = (bf16)f2bf(o * siluf_(bf2f(WSP(bf16, WS_U)[row * DIN + 3072 + h * 64 + lane])));
    }
}

typedef float f32x16 __attribute__((ext_vector_type(16)));
typedef short s16x4 __attribute__((ext_vector_type(4)));
typedef short v4i16_t __attribute__((ext_vector_type(4)));
typedef float f32x2_t __attribute__((ext_vector_type(2))); typedef __bf16 bf16x2_t __attribute__((ext_vector_type(2)));
constexpr int AT_K = 0, AT_V = 16384, AT_DONE = 32768, AT_OST = 33792, AT_BYTES = AT_OST + 8 * 8192;
constexpr float ATT_THR = -32.0f;
__device__ __forceinline__ unsigned cvtpk(float lo, float hi) { f32x2_t v = {lo, hi}; bf16x2_t b = __builtin_convertvector(v, bf16x2_t); return __builtin_bit_cast(unsigned, b); }
__device__ __forceinline__ s16x4 vtr(const LAS unsigned char* p) { return __builtin_bit_cast(s16x4, __builtin_amdgcn_ds_read_tr16_b64_v4i16((LAS v4i16_t*)p)); }
#define AT_WAITBAR() asm volatile("s_waitcnt vmcnt(0) lgkmcnt(0)\n\ts_barrier" ::: "memory")
#define MFMA32(a, b, c) __builtin_amdgcn_mfma_f32_32x32x16_bf16((a), (b), (c), 0, 0, 0)

template <bool DIAG>
__device__ __forceinline__ void attn_tile(const LAS unsigned char* Ks, const LAS unsigned char* Vs, const bf16x8 (&qr)[4], const f32x16& biasv, const bf16x8& TA0, const bf16x8& TA1, const bf16x8& TN1,
                                          f32x16 (&o)[2], float& L, int r32, int hi, int qsh) {
    f32x16 p0, p1;
    { const LAS unsigned char* kb = Ks + hi * 1024 + r32 * 16;
#pragma unroll
      for (int d0 = 0; d0 < 4; ++d0) { const bf16x8 b0 = *(const LAS bf16x8*)(kb + d0 * 2048), b1 = *(const LAS bf16x8*)(kb + d0 * 2048 + 512);
          if (d0 == 0) { p0 = MFMA32(b0, qr[0], biasv); p1 = MFMA32(b1, qr[0], biasv); } else { p0 = MFMA32(b0, qr[d0], p0); p1 = MFMA32(b1, qr[d0], p1); } } }
    f32x16 l0, l1;
#pragma unroll
    for (int r = 0; r < 16; ++r) { p0[r] = fminf(p0[r], 100.f); p1[r] = fminf(p1[r], 100.f); l0[r] = lg2(1.0f + ex2(p0[r])); l1[r] = lg2(1.0f + ex2(p1[r])); }
    if (DIAG) {
#pragma unroll
        for (int r = 0; r < 16; ++r) { const int kv = (r & 3) + 8 * (r >> 2) + 4 * hi; if (!(kv < qsh)) l0[r] = 0.f; if (!(kv + 32 < qsh)) l1[r] = 0.f; }
    }
    u32x4 lw0, lw1, lw2, lw3;
    lw0 = (u32x4){cvtpk(l0[0], l0[1]), cvtpk(l0[2], l0[3]), cvtpk(l0[4], l0[5]), cvtpk(l0[6], l0[7])};
    lw1 = (u32x4){cvtpk(l0[8], l0[9]), cvtpk(l0[10], l0[11]), cvtpk(l0[12], l0[13]), cvtpk(l0[14], l0[15])};
    lw2 = (u32x4){cvtpk(l1[0], l1[1]), cvtpk(l1[2], l1[3]), cvtpk(l1[4], l1[5]), cvtpk(l1[6], l1[7])};
    lw3 = (u32x4){cvtpk(l1[8], l1[9]), cvtpk(l1[10], l1[11]), cvtpk(l1[12], l1[13]), cvtpk(l1[14], l1[15])};
    f32x16 Lv;
#pragma unroll
    for (int r = 0; r < 16; ++r) Lv[r] = L;
    f32x16 s0 = MFMA32(TA0, __builtin_bit_cast(bf16x8, lw0), Lv); s0 = MFMA32(TA1, __builtin_bit_cast(bf16x8, lw1), s0);
    s0 = MFMA32(TN1, __builtin_bit_cast(bf16x8, lw2), s0); s0 = MFMA32(TN1, __builtin_bit_cast(bf16x8, lw3), s0);
    f32x16 s1 = MFMA32(TA0, __builtin_bit_cast(bf16x8, lw2), Lv); s1 = MFMA32(TA1, __builtin_bit_cast(bf16x8, lw3), s1);
#pragma unroll
    for (int r = 0; r < 16; ++r) { p0[r] = ex2(p0[r] + s0[r]); p1[r] = ex2(p1[r] + s1[r]); }
    if (DIAG) {
#pragma unroll
        for (int r = 0; r < 16; ++r) { const int kv = (r & 3) + 8 * (r >> 2) + 4 * hi; if (!(kv < qsh)) p0[r] = 0.f; if (!(kv + 32 < qsh)) p1[r] = 0.f; }
    }
    { const float t = s0[0]; auto rr = __builtin_amdgcn_permlane32_swap(__float_as_uint(t), __float_as_uint(t), false, false);
      L = fminf(__uint_as_float(rr[0]), __uint_as_float(rr[1])); }
    u32x4 pw0, pw1, pw2, pw3;
    pw0 = (u32x4){cvtpk(p0[0], p0[1]), cvtpk(p0[2], p0[3]), cvtpk(p0[4], p0[5]), cvtpk(p0[6], p0[7])};
    pw1 = (u32x4){cvtpk(p0[8], p0[9]), cvtpk(p0[10], p0[11]), cvtpk(p0[12], p0[13]), cvtpk(p0[14], p0[15])};
    pw2 = (u32x4){cvtpk(p1[0], p1[1]), cvtpk(p1[2], p1[3]), cvtpk(p1[4], p1[5]), cvtpk(p1[6], p1[7])};
    pw3 = (u32x4){cvtpk(p1[8], p1[9]), cvtpk(p1[10], p1[11]), cvtpk(p1[12], p1[13]), cvtpk(p1[14], p1[15])};
    const LAS unsigned char* vp = Vs + ((lane_id() >> 4) & 1) * 32 + (lane_id() & 3) * 8 + (4 * hi + ((lane_id() & 15) >> 2)) * 64;
    s16x4 vlo[8], vhi[8];
#pragma unroll
    for (int i = 0; i < 8; ++i) { vlo[i] = vtr(vp + (i >> 2) * 4096 + (i & 3) * 1024); vhi[i] = vtr(vp + (i >> 2) * 4096 + (i & 3) * 1024 + 512); }
#define VFR(i) (bf16x8){vlo[i][0], vlo[i][1], vlo[i][2], vlo[i][3], vhi[i][0], vhi[i][1], vhi[i][2], vhi[i][3]}
    o[0] = MFMA32(__builtin_bit_cast(bf16x8, pw0), VFR(0), o[0]); o[1] = MFMA32(__builtin_bit_cast(bf16x8, pw0), VFR(4), o[1]);
    o[0] = MFMA32(__builtin_bit_cast(bf16x8, pw1), VFR(1), o[0]); o[1] = MFMA32(__builtin_bit_cast(bf16x8, pw1), VFR(5), o[1]);
    o[0] = MFMA32(__builtin_bit_cast(bf16x8, pw2), VFR(2), o[0]); o[1] = MFMA32(__builtin_bit_cast(bf16x8, pw2), VFR(6), o[1]);
    o[0] = MFMA32(__builtin_bit_cast(bf16x8, pw3), VFR(3), o[0]); o[1] = MFMA32(__builtin_bit_cast(bf16x8, pw3), VFR(7), o[1]);
#undef VFR
}

__device__ __forceinline__ void attn_unit(Frame& F, int l, int unit) {
    int tid_l = F.tid; asm volatile("" : "+v"(tid_l)); const int lane = tid_l & 63, r32 = lane & 31, hi = lane >> 5, w = F.wave;
    ARGS_BEGIN; ARG(I_SBB);
    const int bh = unit >> 5, qb = unit & 31, b = bh >> 2, h = bh & 3, q0 = qb * 256;
    const LAS unsigned char* shm = F.lds;
    const bf16* Qw = WSP(bf16, WS_Q) + ((size_t)bh * SEQ + q0 + w * 32) * 64;
    const unsigned char* Kg = (const unsigned char*)(WSP(bf16, WS_KT) + (size_t)bh * 524288) + w * 1024 + lane * 16;
    const unsigned char* Vg = (const unsigned char*)(WSP(bf16, WS_VT) + (size_t)bh * 524288) + w * 1024 + lane * 16;
#define AT_DMA(j, s) do { __builtin_amdgcn_global_load_lds((const unsigned*)(Kg + (size_t)(j) * 8192), (LAS unsigned*)(F.lds + AT_K + (s) * 8192 + w * 1024), 16, 0, 0); \
                          __builtin_amdgcn_global_load_lds((const unsigned*)(Vg + (size_t)(j) * 8192), (LAS unsigned*)(F.lds + AT_V + (s) * 8192 + w * 1024), 16, 0, 0); } while (0)
    volatile LAS int* done = (volatile LAS int*)(F.lds + AT_DONE);
    const int NT = 4 * qb + 4;
    if (tid_l < 8) done[tid_l] = -1;
    AT_DMA(NT - 1, 0);
    bf16x8 qr[4];
#pragma unroll
    for (int d0 = 0; d0 < 4; ++d0) qr[d0] = *(const bf16x8*)(Qw + (size_t)r32 * 64 + d0 * 16 + hi * 8);
    const float bias2 = A.in[I_SBB][l * 4 + h] * LOG2E;
    f32x16 biasv;
#pragma unroll
    for (int r = 0; r < 16; ++r) biasv[r] = bias2;
    bf16x8 TA0, TA1, TN1;
#pragma unroll
    for (int j = 0; j < 8; ++j) { const int kk = 8 * (j >> 2) + 4 * hi + (j & 3); TA0[j] = (kk >= r32) ? (short)0xBF80 : (short)0; TA1[j] = (16 + kk >= r32) ? (short)0xBF80 : (short)0; TN1[j] = (short)0xBF80; }
    f32x16 o[2];
#pragma unroll
    for (int r = 0; r < 16; ++r) { o[0][r] = 0.f; o[1][r] = 0.f; }
    float L = 0.f; bool mydone = false, posted = false;
    const int qsh = r32 + 32 * (w & 1);
    AT_WAITBAR();
    for (int j = NT - 1; j >= 0; --j) {
        const int s = (NT - 1 - j) & 1;
        if (j > 0) AT_DMA(j - 1, s ^ 1);
        const int jb = j - 4 * qb;
        if (!mydone && jb <= (w >> 1)) {
            if (jb == (w >> 1)) attn_tile<true>(shm + AT_K + s * 8192, shm + AT_V + s * 8192, qr, biasv, TA0, TA1, TN1, o, L, r32, hi, qsh);
            else attn_tile<false>(shm + AT_K + s * 8192, shm + AT_V + s * 8192, qr, biasv, TA0, TA1, TN1, o, L, r32, hi, qsh);
            mydone = __all(L < ATT_THR);
        }
        if (mydone && !posted) { if (lane == 0) done[w] = j; posted = true; }
        AT_WAITBAR();
        const int dv = done[lane & 7];
        if (__all(dv >= j)) break;
    }
    { LAS float* stg = (LAS float*)(F.lds + AT_OST + w * 8192);
#pragma unroll
      for (int r = 0; r < 16; ++r) { const int orow = (r & 3) + 8 * (r >> 2) + 4 * hi; stg[orow * 64 + r32] = o[0][r]; stg[orow * 64 + 32 + r32] = o[1][r]; }
      asm volatile("s_waitcnt lgkmcnt(0)" ::: "memory");
      const bf16* Ug = WSP(bf16, WS_U); bf16* Mx = WSP(bf16, WS_MIX);
#pragma unroll
      for (int i = 0; i < 4; ++i) { const int row = i * 8 + (lane >> 3), ch = lane & 7; const size_t grow = (size_t)b * SEQ + q0 + w * 32 + row;
          const f32x4 x0 = *(const LAS f32x4*)(stg + row * 64 + ch * 8), x1 = *(const LAS f32x4*)(stg + row * 64 + ch * 8 + 4);
          const u32x4 g = *(const u32x4*)(Ug + grow * DIN + 3072 + h * 64 + ch * 8);
          u32x4 ov; ov.x = cvtpk(x0[0] * siluf_(bflo(g.x)), x0[1] * siluf_(bfhi(g.x))); ov.y = cvtpk(x0[2] * siluf_(bflo(g.y)), x0[3] * siluf_(bfhi(g.y)));
          ov.z = cvtpk(x1[0] * siluf_(bflo(g.z)), x1[1] * siluf_(bfhi(g.z))); ov.w = cvtpk(x1[2] * siluf_(bflo(g.w)), x1[3] * siluf_(bfhi(g.w)));
          *(u32x4*)(Mx + grow * DM + 768 + h * 64 + ch * 8) = ov; } }
    AT_WAITBAR();
#undef AT_DMA
}

__device__ __forceinline__ void sample_attn_unit(Frame& F, int l, int i) {
    int tid_l = F.tid; asm volatile("" : "+v"(tid_l)); const int lane_l = tid_l & 63;
    ARGS_BEGIN; ARG(I_SBB); ARG(I_PT); ARG(I_CK); ARG(I_CV);
    LAS float* sAcc = (LAS float*)(F.lds);
    LAS float* sL = (LAS float*)(F.lds + 8192);
    const int lane = lane_l, h = lane >> 4, w = F.wave;
    const bf16* ur = WSP(bf16, WS_U) + (size_t)(MP + i) * DIN;
    float q4[4];
    { const unsigned long long qq = *(const unsigned long long*)(ur + 2304 + lane * 4); q4[0] = bflo((unsigned)qq); q4[1] = bfhi((unsigned)qq); q4[2] = bflo((unsigned)(qq >> 32)); q4[3] = bfhi((unsigned)(qq >> 32)); }
    const float bias2 = A.in[I_SBB][l * 4 + h] * LOG2E;
    const int* pt = (const int*)A.in[I_PT] + i * NPG;
    f32x4 acc = {0.f, 0.f, 0.f, 0.f}; float Lrun = 0.f;
#pragma unroll 1
    for (int pg = 1; pg >= 0; --pg) {
        const int page = pt[2 * w + pg];
        const float* kb = A.in[I_CK] + ((size_t)(l * NPOOLPG + page) * PAGE) * 256 + lane * 4;
        const float* vb = A.in[I_CV] + ((size_t)(l * NPOOLPG + page) * PAGE) * 256 + lane * 4;
#pragma unroll 1
        for (int r0 = PAGE - 8; r0 >= 0; r0 -= 8) {
            f32x4 k4[8], v4[8];
#pragma unroll
            for (int jj = 0; jj < 8; ++jj) { k4[jj] = *(const f32x4*)(kb + (size_t)(r0 + jj) * 256); v4[jj] = *(const f32x4*)(vb + (size_t)(r0 + jj) * 256); }
#pragma unroll
            for (int jj = 7; jj >= 0; --jj) {
                float p = q4[0] * k4[jj].x + q4[1] * k4[jj].y + q4[2] * k4[jj].z + q4[3] * k4[jj].w;
                p += __shfl_xor(p, 1); p += __shfl_xor(p, 2); p += __shfl_xor(p, 4); p += __shfl_xor(p, 8);
                const float z2 = fminf(p + bias2, 100.f); const float lk = -lg2(1.0f + ex2(z2)); const float a = ex2(z2 + lk + Lrun); Lrun += lk;
                acc = acc + v4[jj] * a;
            }
        }
    }
    *(LAS f32x4*)(sAcc + w * 256 + lane * 4) = acc; if ((lane & 15) == 0) sL[w * 4 + h] = Lrun;
    __syncthreads();
    if (tid_l < 256) { const int hh = tid_l >> 6; float o = 0.f, Ls = 0.f;
#pragma unroll 1
        for (int ww = 7; ww >= 0; --ww) { o += ex2(Ls) * sAcc[ww * 256 + tid_l]; Ls += sL[ww * 4 + hh]; }
        WSP(bf16, WS_MIX)[(size_t)(MP + i) * DM + 768 + tid_l] = (bf16)f2bf(o * siluf_(bf2f(ur[3072 + tid_l]))); }
    __syncthreads();
}

__device__ __forceinline__ void sample_outproj(Frame& F, int l) {
    int tid_l = F.tid; asm volatile("" : "+v"(tid_l)); const int lane_l = tid_l & 63;
    ARGS_BEGIN; ARG(I_XS);
    const float* base = (l == 0) ? A.in[I_XS] : WSP(float, WS_XF) + (size_t)MP * DM;
    const bf16* W = WSP(bf16, WS_WOUTT) + (size_t)l * DM * DM;
    for (int o = F.vcu * 512 + tid_l; o < DECB * DM; o += F.G * 512) { const int i = o >> 10, col = o & 1023;
        const u32x4* a = (const u32x4*)(WSP(bf16, WS_MIX) + (size_t)(MP + i) * DM); const u32x4* wv = (const u32x4*)(W + (size_t)col * DM); float s = 0.f;
        for (int k = 0; k < DM / 8; ++k) { const u32x4 x = a[k], y = wv[k];
            s += bflo(x.x) * bflo(y.x) + bfhi(x.x) * bfhi(y.x) + bflo(x.y) * bflo(y.y) + bfhi(x.y) * bfhi(y.y) + bflo(x.z) * bflo(y.z) + bfhi(x.z) * bfhi(y.z) + bflo(x.w) * bflo(y.w) + bfhi(x.w) * bfhi(y.w); }
        WSP(float, WS_PRE)[(size_t)(MP + i) * DM + col] = ALPHA * base[(size_t)i * DM + col] + s; }
}

__device__ __forceinline__ void ln_rows(Frame& F, int l) {
    int tid_l = F.tid; asm volatile("" : "+v"(tid_l)); const int lane_l = tid_l & 63;
    ARGS_BEGIN; ARG(I_LNG); ARG(I_LNB);
    const int gw = F.vcu * NWAVES + F.wave, NGW = F.G * NWAVES, lane = lane_l;
    const float* g = A.in[I_LNG] + l * DM; const float* bb = A.in[I_LNB] + l * DM;
    for (int m = gw; m < MLN; m += NGW) {
        const f32x4* xr = (const f32x4*)(WSP(float, WS_PRE) + (size_t)m * DM) + lane; f32x4 v[4]; float s = 0.f;
#pragma unroll
        for (int j = 0; j < 4; ++j) { v[j] = xr[64 * j]; s += (v[j].x + v[j].y) + (v[j].z + v[j].w); }
        const float mean = wave_sum(s) * (1.f / DM); float s2 = 0.f;
#pragma unroll
        for (int j = 0; j < 4; ++j) { v[j] = v[j] - mean; s2 += (v[j].x * v[j].x + v[j].y * v[j].y) + (v[j].z * v[j].z + v[j].w * v[j].w); }
        const float rstd = 1.f / sqrtf(wave_sum(s2) * (1.f / DM) + LN_EPS);
        float* dst = (l == DEPTH - 1) ? (m < MP ? A.out + O_YP + (size_t)m * DM : A.out + O_YS + (size_t)(m - MP) * DM) : WSP(float, WS_XF) + (size_t)m * DM;
        unsigned long long* o8 = (unsigned long long*)(WSP(bf16, WS_XB) + (size_t)m * DM) + lane;
#pragma unroll
        for (int j = 0; j < 4; ++j) { const f32x4 gg = ((const f32x4*)g)[64 * j + lane], bv = ((const f32x4*)bb)[64 * j + lane];
            const f32x4 y = v[j] * rstd * gg + bv; ((f32x4*)dst)[64 * j + lane] = y;
            o8[64 * j] = (unsigned long long)pk2(y.x, y.y) | ((unsigned long long)pk2(y.z, y.w) << 32); }
    }
}
__global__ void __launch_bounds__(NWAVES * 64, 2) fwd_kernel(Args args) {
    extern __shared__ __attribute__((aligned(16))) unsigned char lds[];
    Frame F;
    F.lds = (LAS unsigned char*)lds;
    F.MISC = (volatile LAS unsigned*)(F.lds + MISC_OFF);
    F.tid = threadIdx.x; F.lane = F.tid & 63; F.wave = __builtin_amdgcn_readfirstlane(F.tid >> 6);
    F.G = gridDim.x; { const int bx = blockIdx.x; F.vcu = (F.G % 8 == 0) ? (bx % 8) * (F.G / 8) + bx / 8 : bx; }
    F.ctl = (gu32*)(KWS + WS_CTL);
    for (int u = F.tid; u < (LDS_BYTES - LDSCTL_OFF) / 4; u += NWAVES * 64) ((LAS unsigned*)(F.lds + LDSCTL_OFF))[u] = 0u;
    __syncthreads();
    XcdBarrier bar = xcd_barrier_post((unsigned*)(F.ctl + CW_BAR), F.MISC + 8);

#ifndef SK_PRO
    prologue(F);
#endif
    xcd_barrier(bar);
#pragma unroll
    for (int l = 0; l < DEPTH; ++l) {
#ifndef SK_P1
        { ARGS_BEGIN; pg8::Gemm g{WSP(bf16, WS_XB), WSP(bf16, WS_WINT) + (size_t)l * DIN * DM, MTOT, DIN, DM}; pg8::StaticOrder S; S.init(MTOT, DIN, F.G, (int)blockIdx.x);
          pg8::EpiIn E{WSP(bf16, WS_U), WSP(bf16, WS_Q), WSP(bf16, WS_KT), WSP(bf16, WS_VT), A.out + O_KP + (size_t)l * MP * 256, A.out + O_VP + (size_t)l * MP * 256, A.out + O_KS + (size_t)l * DECB * 256, A.out + O_VS + (size_t)l * DECB * 256};
          pg8::gemm_phase<pg8::EpiIn, pg8::StaticOrder, true, true>(F.lds + RING_OFF, g, S, E); }
#endif
        xcd_barrier(bar);
#ifndef SK_MIX
        for (int u = F.vcu; u < 512; u += F.G) mixer_unit(F, l, u);
#endif
#ifndef SK_SMP
        for (int i = F.vcu; i < DECB; i += F.G) { sample_mixer_unit(F, l, i); sample_attn_unit(F, l, i); }
#endif
#ifdef USE_NAIVE_ATT
        attn_naive(F, l);
#else
        for (int u = F.vcu; u < 256; u += F.G) attn_unit(F, l, u);
#endif
        xcd_barrier(bar);
#ifndef SK_P3
        { ARGS_BEGIN; ARG(I_XP); pg8::Gemm g{WSP(bf16, WS_MIX), WSP(bf16, WS_WOUTT) + (size_t)l * DM * DM, MP, DM, DM}; pg8::StaticOrder S; S.init(MP, DM, F.G, (int)blockIdx.x);
          pg8::EpiPre E{(l == 0) ? A.in[I_XP] : WSP(float, WS_XF), WSP(float, WS_PRE), ALPHA};
          pg8::gemm_phase<pg8::EpiPre, pg8::StaticOrder, true, true>(F.lds + RING_OFF, g, S, E); }
#endif
#ifndef SK_SOP
        sample_outproj(F, l);
#endif
        xcd_barrier(bar);
#ifndef SK_LN
        ln_rows(F, l);
#endif
        if (l + 1 < DEPTH) xcd_barrier(bar);
    }
}

extern "C" void kernel_launch(void* const* d_in, const int* in_sizes, int n_in, void* d_out, int out_size, void* d_ws, size_t ws_size, hipStream_t stream) {
    static int grid = 0;
    if (grid == 0) {
        if (n_in != 20 || out_size != (int)O_END || ws_size < WS_END) { fprintf(stderr, "kernel_launch: unexpected shapes: n_in %d out %d ws %zu\n", n_in, out_size, ws_size); grid = -1; return; }
        int dev = 0, cus = 0, per_cu = 0;
        if (hipGetDevice(&dev) != hipSuccess || hipDeviceGetAttribute(&cus, hipDeviceAttributeMultiprocessorCount, dev) != hipSuccess) { grid = -1; return; }
        if (hipFuncSetAttribute((const void*)fwd_kernel, hipFuncAttributeMaxDynamicSharedMemorySize, LDS_BYTES) != hipSuccess) { fprintf(stderr, "kernel_launch: hipFuncSetAttribute failed\n"); grid = -1; return; }
        if (hipOccupancyMaxActiveBlocksPerMultiprocessor(&per_cu, (const void*)fwd_kernel, NWAVES * 64, LDS_BYTES) != hipSuccess || per_cu < 1)
            fprintf(stderr, "kernel_launch: occupancy query reports %d workgroups per CU\n", per_cu);
        (void)hipGetLastError();
        grid = cus;
    }
    if (grid < 0) return;
    if (hipMemsetAsync((char*)d_ws + WS_CTL, 0, CTL_ZERO_BYTES, stream) != hipSuccess) return;
    Args a{};
    for (int i = 0; i < 20; ++i) a.in[i] = (const float*)d_in[i];
    a.out = (float*)d_out; a.ws = (unsigned char*)d_ws;
    hipLaunchKernelGGL(fwd_kernel, dim3(grid), dim3(NWAVES * 64), LDS_BYTES, stream, a);
}
```
